# Optimizing an MI355X kernel written in HIP

```python
import jax, jax.numpy as jnp
from jax import lax
import numpy as np

D_MODEL = 1024
BATCH = 2
SEQ = 16384
DEPTH = 1
DEC_BATCH = 1
DEC_SEQ = 16384
PAST_LEN = 128

GRID_W = 64
EPS = 1e-6
GLA_HEADS = 4
GLA_DK = 64
GLA_DV = 128
GLA_RANK = 16
GLA_GATE_NORM = 16.0
GLA_CHUNK = 64
GLA_QK_WIDTH = GLA_HEADS * GLA_DK
GLA_WIDTH = GLA_HEADS * GLA_DV
ATT_HEADS = 8
ATT_KV_HEADS = 2
ATT_GROUP = ATT_HEADS // ATT_KV_HEADS
ATT_HD = 64
ATT_BLOCK = 128
ROPE_THETA = 10000.0
ATT_WIDTH = ATT_HEADS * ATT_HD
ATT_KV_WIDTH = ATT_KV_HEADS * ATT_HD
MIX_WIDTH = GLA_WIDTH + ATT_WIDTH
IN_SIZES = (GLA_QK_WIDTH, GLA_QK_WIDTH, GLA_WIDTH, GLA_WIDTH, GLA_RANK, GLA_RANK,
            ATT_WIDTH, ATT_KV_WIDTH, ATT_KV_WIDTH)
IN_WIDTH = sum(IN_SIZES)
D_FF = 2816
CONV_W = 3

kernel_name = "hymba_gla_axialgqa_convffn_encoder"


def rmsnorm(x, w):
    xf = x.astype(jnp.float32)
    y = xf * lax.rsqrt(jnp.mean(xf * xf, axis=-1, keepdims=True) + EPS)
    return (y * w.astype(jnp.float32)).astype(x.dtype)


def axial_rope_tables(L):
    rows = L // GRID_W
    row = jnp.repeat(jnp.arange(rows), GRID_W).astype(jnp.float32)
    col = jnp.tile(jnp.arange(GRID_W), rows).astype(jnp.float32)
    half = ATT_HD // 2
    inv = 1.0 / (ROPE_THETA ** (jnp.arange(0, half, 2, dtype=jnp.float32) / half))
    ang_r = row[:, None] * inv
    ang_c = col[:, None] * inv
    return (jnp.cos(ang_r), jnp.sin(ang_r), jnp.cos(ang_c), jnp.sin(ang_c))


def _rotate(x, cos, sin):
    h = x.shape[-1] // 2
    x1, x2 = x[..., :h], x[..., h:]
    return jnp.concatenate([x1 * cos - x2 * sin, x1 * sin + x2 * cos], axis=-1)


def apply_axial_rope(x, tabs):
    cr, sr, cc, sc = tabs
    h = ATT_HD // 2
    return jnp.concatenate([_rotate(x[..., :h], cr, sr), _rotate(x[..., h:], cc, sc)], axis=-1)


def gla_chunked(q, k, v, gk):
    B, H, L, dk = q.shape
    dv = v.shape[-1]
    C = GLA_CHUNK
    N = L // C
    q = q.reshape(B, H, N, C, dk)
    k = k.reshape(B, H, N, C, dk)
    v = v.reshape(B, H, N, C, dv)
    b = jnp.cumsum(gk.reshape(B, H, N, C, dk), axis=3)
    b_last = b[..., -1:, :]
    qt = q * jnp.exp(b)
    kt = k * jnp.exp(-b)
    kend = k * jnp.exp(b_last - b)
    mask = jnp.tril(jnp.ones((C, C), dtype=bool))
    A = jnp.where(mask, jnp.einsum('bhncd,bhnsd->bhncs', qt, kt), 0.0)
    o_intra = jnp.einsum('bhncs,bhnse->bhnce', A, v)
    s_chunk = jnp.einsum('bhncd,bhnce->bhnde', kend, v)
    decay = jnp.exp(b_last[..., 0, :])

    def step(S, inp):
        s_c, d_c = inp
        return S * d_c[..., None] + s_c, S

    _, s_prev = lax.scan(step, jnp.zeros((B, H, dk, dv), jnp.float32),
                         (jnp.moveaxis(s_chunk, 2, 0), jnp.moveaxis(decay, 2, 0)))
    s_prev = jnp.moveaxis(s_prev, 0, 2)
    o_inter = jnp.einsum('bhncd,bhnde->bhnce', qt, s_prev)
    return (o_intra + o_inter).reshape(B, H, L, dv)


def gla_group(q, k, v, g, r_f, r_b, w_gk_f, b_gk_f, w_gk_b, b_gk_b, o_norm):
    B, L, _ = q.shape

    def heads(t, d):
        return t.reshape(B, L, GLA_HEADS, d).transpose(0, 2, 1, 3).astype(jnp.float32)

    gk_f = jax.nn.log_sigmoid((r_f @ w_gk_f + b_gk_f).astype(jnp.float32)) / GLA_GATE_NORM
    gk_b = jax.nn.log_sigmoid((r_b @ w_gk_b + b_gk_b).astype(jnp.float32)) / GLA_GATE_NORM
    qh = heads(q, GLA_DK) * (GLA_DK ** -0.5)
    kh = heads(k, GLA_DK)
    vh = heads(v, GLA_DV)
    gf = heads(gk_f, GLA_DK)
    gb = heads(gk_b, GLA_DK)
    o_fwd = gla_chunked(qh, kh, vh, gf)
    flip = lambda t: jnp.flip(t, axis=2)
    o_bwd = flip(gla_chunked(flip(qh), flip(kh), flip(vh), flip(gb)))
    o = (o_fwd + o_bwd).transpose(0, 2, 1, 3)
    o = rmsnorm(o, o_norm).reshape(B, L, GLA_WIDTH)
    return (o * jax.nn.silu(g.astype(jnp.float32))).astype(q.dtype)


def gqa_group(q, k, v, q_norm, k_norm, rope):
    B, L, _ = q.shape
    q = rmsnorm(q.reshape(B, L, ATT_KV_HEADS, ATT_GROUP, ATT_HD), q_norm).astype(jnp.float32)
    k = rmsnorm(k.reshape(B, L, ATT_KV_HEADS, ATT_HD), k_norm).astype(jnp.float32)
    v = v.reshape(B, L, ATT_KV_HEADS, ATT_HD).transpose(0, 2, 1, 3)
    q = apply_axial_rope(q.transpose(0, 2, 3, 1, 4), rope).astype(v.dtype)
    k = apply_axial_rope(k.transpose(0, 2, 1, 3), rope).astype(v.dtype)
    nb = L // ATT_BLOCK
    qb = q.reshape(B, ATT_KV_HEADS, ATT_GROUP, nb, ATT_BLOCK, ATT_HD).transpose(3, 0, 1, 2, 4, 5)
    scale = ATT_HD ** -0.5

    def one_block(qblk):
        s = jnp.einsum('bhgqd,bhkd->bhgqk', qblk, k).astype(jnp.float32) * scale
        p = jax.nn.softmax(s, axis=-1)
        return jnp.einsum('bhgqk,bhkd->bhgqd', p.astype(v.dtype), v)

    o = lax.map(one_block, qb)
    return o.transpose(1, 0, 4, 2, 3, 5).reshape(B, L, ATT_WIDTH)


def mixer_block(h, w_in, w_gk_f, b_gk_f, w_gk_b, b_gk_b, o_norm, q_norm, k_norm, w_out, rope):
    proj = h @ w_in
    points = [int(p) for p in np.cumsum(IN_SIZES)[:-1]]
    gq, gk, gv, gg, rf, rb, aq, ak, av = jnp.split(proj, points, axis=-1)
    o_gla = gla_group(gq, gk, gv, gg, rf, rb, w_gk_f, b_gk_f, w_gk_b, b_gk_b, o_norm)
    o_att = gqa_group(aq, ak, av, q_norm, k_norm, rope)
    return jnp.concatenate([o_gla, o_att.astype(o_gla.dtype)], axis=-1) @ w_out


def conv_ffn(h, w_up, conv_w, conv_b, w_down):
    u = h @ w_up
    up = jnp.pad(u, ((0, 0), (1, 1), (0, 0)))
    u = up[:, :-2] * conv_w[0] + up[:, 1:-1] * conv_w[1] + up[:, 2:] * conv_w[2] + conv_b
    a, gate = jnp.split(u, 2, axis=-1)
    return (jax.nn.silu(gate) * a) @ w_down


def encoder_trunk(x, ln_mix, w_in, w_gk_fwd, b_gk_fwd, w_gk_bwd, b_gk_bwd, gla_out_norm,
                  q_norm, k_norm, w_out, ln_ffn, w_up, conv_w, conv_b, w_down, ln_final):
    rope = axial_rope_tables(x.shape[1])
    for l in range(DEPTH):
        x = x + mixer_block(rmsnorm(x, ln_mix[l]), w_in[l], w_gk_fwd[l], b_gk_fwd[l],
                            w_gk_bwd[l], b_gk_bwd[l], gla_out_norm[l], q_norm[l], k_norm[l],
                            w_out[l], rope)
        x = x + conv_ffn(rmsnorm(x, ln_ffn[l]), w_up[l], conv_w[l], conv_b[l], w_down[l])
    return rmsnorm(x, ln_final)


def setup_inputs(seed: int = 0) -> dict:
    key = jax.random.key(seed)
    ks = jax.random.split(key, 20)
    f32 = jnp.float32
    nrm = lambda k, shape, s: jax.random.normal(k, shape, f32) * s
    gain = lambda k, shape: 1.0 + 0.02 * jax.random.normal(k, shape, f32)
    return {
        "x_prompt": jax.random.normal(ks[0], (BATCH, SEQ, D_MODEL), f32),
        "x_sample": jax.random.normal(ks[1], (DEC_BATCH, DEC_SEQ, D_MODEL), f32),
        "ln_mix": gain(ks[2], (DEPTH, D_MODEL)),
        "w_in": nrm(ks[3], (DEPTH, D_MODEL, IN_WIDTH), D_MODEL ** -0.5),
        "w_gk_fwd": nrm(ks[4], (DEPTH, GLA_RANK, GLA_QK_WIDTH), GLA_RANK ** -0.5),
        "b_gk_fwd": nrm(ks[5], (DEPTH, GLA_QK_WIDTH), 0.1),
        "w_gk_bwd": nrm(ks[6], (DEPTH, GLA_RANK, GLA_QK_WIDTH), GLA_RANK ** -0.5),
        "b_gk_bwd": nrm(ks[7], (DEPTH, GLA_QK_WIDTH), 0.1),
        "gla_out_norm": gain(ks[8], (DEPTH, GLA_DV)),
        "q_norm": gain(ks[9], (DEPTH, ATT_HD)),
        "k_norm": gain(ks[10], (DEPTH, ATT_HD)),
        "w_out": nrm(ks[11], (DEPTH, MIX_WIDTH, D_MODEL), MIX_WIDTH ** -0.5),
        "ln_ffn": gain(ks[12], (DEPTH, D_MODEL)),
        "w_up": nrm(ks[13], (DEPTH, D_MODEL, 2 * D_FF), D_MODEL ** -0.5),
        "conv_w": nrm(ks[14], (DEPTH, CONV_W, 2 * D_FF), CONV_W ** -0.5),
        "conv_b": nrm(ks[15], (DEPTH, 2 * D_FF), 0.02),
        "w_down": nrm(ks[16], (DEPTH, D_FF, D_MODEL), D_FF ** -0.5),
        "ln_final": gain(ks[17], (D_MODEL,)),
    }


def reference(x_prompt, x_sample, ln_mix, w_in, w_gk_fwd, b_gk_fwd, w_gk_bwd, b_gk_bwd,
              gla_out_norm, q_norm, k_norm, w_out, ln_ffn, w_up, conv_w, conv_b, w_down,
              ln_final):
    y_prompt = encoder_trunk(x_prompt, ln_mix, w_in, w_gk_fwd, b_gk_fwd, w_gk_bwd, b_gk_bwd,
                             gla_out_norm, q_norm, k_norm, w_out, ln_ffn, w_up, conv_w,
                             conv_b, w_down, ln_final)
    y_sample = encoder_trunk(x_sample, ln_mix, w_in, w_gk_fwd, b_gk_fwd, w_gk_bwd, b_gk_bwd,
                             gla_out_norm, q_norm, k_norm, w_out, ln_ffn, w_up, conv_w,
                             conv_b, w_down, ln_final)
    return (y_prompt, y_sample)
```

```cpp
#include <hip/hip_runtime.h>
#include <cstdio>
#include <cstdint>
namespace pg8 {
#define PG8_LAS __attribute__((address_space(3)))
typedef unsigned short bf16_t;
typedef short bf16x8 __attribute__((ext_vector_type(8)));
typedef float f32x4 __attribute__((ext_vector_type(4)));
typedef unsigned u32x4 __attribute__((ext_vector_type(4)));
constexpr int BM = 256, BK = 64, HALF = 128, HTB = HALF * BK * 2  , STAGE_BYTES = 8 * HTB, NXCD = 8, WGM = 8;

__host__ __device__ __forceinline__ int lds_byte(int r, int c) { const int st = (r >> 4) * 2 + (c >> 5), rr = r & 15, cc = c & 31, ob = rr * 64 + cc * 2; return st * 1024 + (ob ^ (((ob >> 9) & 1) << 5)); }
__host__ __device__ __forceinline__ void stage_rc(int b, int& R, int& C) { const int st = b / 1024, sb = b % 1024, swz = sb ^ (((sb >> 9) & 1) << 5); R = (st >> 1) * 16 + swz / 64; C = (st & 1) * 32 + (swz % 64) / 2; }
__host__ __device__ __forceinline__ int perm32(int rho) { const int n = rho >> 4, i = rho & 15; return 8 * (i >> 2) + 4 * n + (i & 3); }

struct Unit { int pm, pn, arow; };
struct Gemm { const bf16_t* A; const bf16_t* Bt; int M, N, K; };

struct StaticOrder {
    int nM, nN, nwg, G, c, aoff;
    __host__ __device__ void init(int M, int N, int G_, int c_, int aoff_) { nM = M / BM; nN = N / BM; nwg = nM * nN; G = G_; c = c_; aoff = aoff_; }
    __host__ __device__ bool next(int i, Unit& u) const {
        const long L = (long)i * G + c; if (L >= nwg) return false;
        int wgid = (int)L; { const int q = nwg / NXCD, r = nwg % NXCD, xcd = wgid % NXCD, off = wgid / NXCD; wgid = (xcd < r ? xcd * (q + 1) : r * (q + 1) + (xcd - r) * q) + off; }
        const int nig = WGM * nN, gid = wgid / nig, fm = gid * WGM, gsz = (nM - fm) < WGM ? (nM - fm) : WGM;
        u.pm = fm + ((wgid % nig) % gsz); u.pn = (wgid % nig) / gsz; u.arow = aoff + u.pm * BM; return true;
    }
    __device__ __forceinline__ void a_ready(const Unit&) const {}
    __device__ __forceinline__ void done(const Unit&) const {}
};

typedef float f32x2c __attribute__((ext_vector_type(2))); typedef __bf16 bf16x2c __attribute__((ext_vector_type(2)));
__device__ __forceinline__ unsigned cvt_pk_bf16(float lo, float hi) { const f32x2c v = {lo, hi}; const bf16x2c b = __builtin_convertvector(v, bf16x2c); return __builtin_bit_cast(unsigned, b); }
typedef float f32x2 __attribute__((ext_vector_type(2)));
__device__ __forceinline__ f32x2 gelu_pk(f32x2 v) {
    const f32x2 av = __builtin_elementwise_abs(v), d = av * 0.2316418882f + 1.0f;
    f32x2 t; t.x = __builtin_amdgcn_rcpf(d.x); t.y = __builtin_amdgcn_rcpf(d.y);
    f32x2 q = t * 0.5307027145f + (-0.7265760135f); q = q * t + 0.7107068705f; q = q * t + (-0.142248368f); q = q * t + 0.127414796f; q = q * t;
    const f32x2 s = (v * v) * (-0.72134752044f);
    f32x2 e; e.x = __builtin_amdgcn_exp2f(s.x); e.y = __builtin_amdgcn_exp2f(s.y);
    const f32x2 m = v * (q * e), r = v - m;
    f32x2 o; o.x = v.x < 0.f ? m.x : r.x; o.y = v.y < 0.f ? m.y : r.y; return o;
}

template <int ACT  > struct EpiBf16 {
    static constexpr bool PERM = true, AFTER_DRAIN = false, APERM = false; static_assert(ACT == 0 || ACT == 1, "EpiBf16: ACT is 0 (none) or 1 (gelu_pk)");
    bf16_t* O; int ldc; const float* bias; int split_cols; size_t split_stride; float scale0;
    __device__ __forceinline__ void operator()(const f32x4 (&acc)[2][2][4][2], const Unit& u, int wr, int wc, int fr, int fq) const {
        const int row0 = u.pm * BM + wr * 64 + fr; int colt = u.pn * BM; bf16_t* base = O;
        float sc = 1.f; if (split_cols) { const int t = colt / split_cols; base += (size_t)t * split_stride; colt -= t * split_cols; if (t == 0) sc = scale0; }
        const int col0 = colt + wc * 32 + 8 * fq, bcol0 = u.pn * BM + wc * 32 + 8 * fq;
        f32x4 bv[2][2];
#pragma unroll
        for (int bj = 0; bj < 2; ++bj)
#pragma unroll
            for (int n = 0; n < 2; ++n) bv[bj][n] = bias ? *(const f32x4*)(bias + bcol0 + bj * HALF + 4 * n) : (f32x4){0.f, 0.f, 0.f, 0.f};
#pragma unroll
        for (int ai = 0; ai < 2; ++ai)
#pragma unroll
            for (int m = 0; m < 4; ++m) { bf16_t* rowp = base + (size_t)(row0 + ai * HALF + m * 16) * ldc + col0;
#pragma unroll
                for (int bj = 0; bj < 2; ++bj) { f32x4 v0 = acc[ai][bj][m][0] + bv[bj][0], v1 = acc[ai][bj][m][1] + bv[bj][1];
                    if (ACT == 1) { f32x2 a = gelu_pk((f32x2){v0[0], v0[1]}), b = gelu_pk((f32x2){v0[2], v0[3]}), c = gelu_pk((f32x2){v1[0], v1[1]}), d = gelu_pk((f32x2){v1[2], v1[3]});
                        v0 = (f32x4){a.x, a.y, b.x, b.y}; v1 = (f32x4){c.x, c.y, d.x, d.y}; }
                    v0 = v0 * sc; v1 = v1 * sc; u32x4 w; w.x = cvt_pk_bf16(v0[0], v0[1]); w.y = cvt_pk_bf16(v0[2], v0[3]); w.z = cvt_pk_bf16(v1[0], v1[1]); w.w = cvt_pk_bf16(v1[2], v1[3]);
                    *(u32x4*)(rowp + bj * HALF) = w; } }
    }
};
struct EpiResid {
    static constexpr bool PERM = false, AFTER_DRAIN = false, APERM = false;
    const float* base0; const float* base1; int split_row; float* out;
    __device__ __forceinline__ void operator()(const f32x4 (&acc)[2][2][4][2], const Unit& u, int wr, int wc, int fr, int fq) const {
#pragma unroll
        for (int ai = 0; ai < 2; ++ai)
#pragma unroll
            for (int m = 0; m < 4; ++m) {
                const int row = u.pm * BM + ai * HALF + wr * 64 + m * 16 + fr;
                const float* bp = row < split_row ? base0 + (size_t)row * 1024 : base1 + (size_t)(row - split_row) * 1024;
                float* op = out + (size_t)row * 1024;
#pragma unroll
                for (int bj = 0; bj < 2; ++bj)
#pragma unroll
                    for (int n = 0; n < 2; ++n) { const int col = u.pn * BM + bj * HALF + wc * 32 + n * 16 + fq * 4;
                        const f32x4 b = *(const f32x4*)(bp + col); *(f32x4*)(op + col) = b + acc[ai][bj][m][n]; }
            }
    }
};
struct EpiResidNorm {
    static constexpr bool PERM = true, AFTER_DRAIN = false, APERM = false;
    const float* base0; const float* base1; int split_row; float* out; bf16_t* h2; const float* ln; float* ssq;
    __device__ __forceinline__ void operator()(const f32x4 (&acc)[2][2][4][2], const Unit& u, int wr, int wc, int fr, int fq) const {
        typedef unsigned u32x4v __attribute__((ext_vector_type(4)));
#pragma unroll
        for (int ai = 0; ai < 2; ++ai)
#pragma unroll
            for (int m = 0; m < 4; ++m) {
                const int row = u.pm * BM + ai * HALF + wr * 64 + m * 16 + fr;
                const float* bp = row < split_row ? base0 + (size_t)row * 1024 : base1 + (size_t)(row - split_row) * 1024;
                bf16_t* hp = h2 + (size_t)row * 1024; float s = 0.f;
#pragma unroll
                for (int bj = 0; bj < 2; ++bj) { const int col = u.pn * BM + bj * HALF + wc * 32 + fq * 8;
                    const f32x4 x0 = *(const f32x4*)(bp + col) + acc[ai][bj][m][0], x1 = *(const f32x4*)(bp + col + 4) + acc[ai][bj][m][1];
                    const f32x4 g0 = *(const f32x4*)(ln + col), g1 = *(const f32x4*)(ln + col + 4);
                    s += ((x0[0] * x0[0] + x0[1] * x0[1]) + (x0[2] * x0[2] + x0[3] * x0[3])) + ((x1[0] * x1[0] + x1[1] * x1[1]) + (x1[2] * x1[2] + x1[3] * x1[3]));
                    u32x4v w; w.x = cvt_pk_bf16(x0[0] * g0[0], x0[1] * g0[1]); w.y = cvt_pk_bf16(x0[2] * g0[2], x0[3] * g0[3]); w.z = cvt_pk_bf16(x1[0] * g1[0], x1[1] * g1[1]); w.w = cvt_pk_bf16(x1[2] * g1[2], x1[3] * g1[3]);
                    *(u32x4v*)(hp + col) = w; }
                s += __shfl_xor(s, 16); s += __shfl_xor(s, 32);
                if (fq == 0) atomicAdd(ssq + row, s);
            }
    }
};
struct EpiDown {
    static constexpr bool PERM = true, AFTER_DRAIN = false, APERM = false;
    const bf16_t* h2; const float* ln; bf16_t* x2b; float* ssq2;
    __device__ __forceinline__ void operator()(const f32x4 (&acc)[2][2][4][2], const Unit& u, int wr, int wc, int fr, int fq) const {
        typedef unsigned u32x4v __attribute__((ext_vector_type(4)));
#pragma unroll
        for (int ai = 0; ai < 2; ++ai)
#pragma unroll
            for (int m = 0; m < 4; ++m) {
                const int row = u.pm * BM + ai * HALF + wr * 64 + m * 16 + fr;
                const bf16_t* hp = h2 + (size_t)row * 1024; bf16_t* op = x2b + (size_t)row * 1024; float s = 0.f;
#pragma unroll
                for (int bj = 0; bj < 2; ++bj) { const int col = u.pn * BM + bj * HALF + wc * 32 + fq * 8;
                    const u32x4v hw = *(const u32x4v*)(hp + col); const f32x4 g0 = *(const f32x4*)(ln + col), g1 = *(const f32x4*)(ln + col + 4);
                    f32x4 x0, x1;
                    x0[0] = __uint_as_float(hw.x << 16) / g0[0]; x0[1] = __uint_as_float(hw.x & 0xffff0000u) / g0[1]; x0[2] = __uint_as_float(hw.y << 16) / g0[2]; x0[3] = __uint_as_float(hw.y & 0xffff0000u) / g0[3];
                    x1[0] = __uint_as_float(hw.z << 16) / g1[0]; x1[1] = __uint_as_float(hw.z & 0xffff0000u) / g1[1]; x1[2] = __uint_as_float(hw.w << 16) / g1[2]; x1[3] = __uint_as_float(hw.w & 0xffff0000u) / g1[3];
                    x0 += acc[ai][bj][m][0]; x1 += acc[ai][bj][m][1];
                    s += ((x0[0] * x0[0] + x0[1] * x0[1]) + (x0[2] * x0[2] + x0[3] * x0[3])) + ((x1[0] * x1[0] + x1[1] * x1[1]) + (x1[2] * x1[2] + x1[3] * x1[3]));
                    u32x4v w; w.x = cvt_pk_bf16(x0[0], x0[1]); w.y = cvt_pk_bf16(x0[2], x0[3]); w.z = cvt_pk_bf16(x1[0], x1[1]); w.w = cvt_pk_bf16(x1[2], x1[3]); *(u32x4v*)(op + col) = w; }
                s += __shfl_xor(s, 16); s += __shfl_xor(s, 32);
                if (fq == 0) atomicAdd(ssq2 + row, s);
            }
    }
};
struct EpiConvGate {
    static constexpr bool PERM = false, AFTER_DRAIN = true, APERM = false;
    bf16_t* act; const float* cw; const float* cb; int tt0; int tokbase; const float* ssq;
    __device__ __forceinline__ void fused(f32x4 (&acc)[2][2][4][2], const Unit& u, int wr, int wc, int fr, int fq, PG8_LAS unsigned char* lds, int wid, int lane) const {
        constexpr int ROWB = 528, SEQL = 16384, NUP = 5632, DFF = 2816;
        typedef unsigned u32x2 __attribute__((ext_vector_type(2)));
        f32x4 wa[2][4], wg[2][4];
#pragma unroll
        for (int n = 0; n < 1; ++n) { const int ca = u.pn * HALF + wc * 32 + n * 16 + fq * 4, cg = DFF + ca;
#pragma unroll
            for (int k = 0; k < 3; ++k) { wa[n][k] = *(const f32x4*)(cw + k * NUP + ca); wg[n][k] = *(const f32x4*)(cw + k * NUP + cg); }
            wa[n][3] = *(const f32x4*)(cb + ca); wg[n][3] = *(const f32x4*)(cb + cg); }
#pragma unroll
        for (int ai = 0; ai < 2; ++ai)
#pragma unroll
            for (int m = 0; m < 4; ++m) {
                const int j = ai * HALF + wr * 64 + m * 16 + fr; const bool valid = (unsigned)(tt0 + j) < (unsigned)SEQL;
                const float q = ssq[valid ? tokbase + tt0 + j : 0]; const float rs = valid ? 1.0f / sqrtf(q * (1.0f / 1024.0f) + 1e-6f) : 0.f;
#pragma unroll
                for (int bj = 0; bj < 2; ++bj)
#pragma unroll
                    for (int n = 0; n < 2; ++n) { const f32x4 v = acc[ai][bj][m][n] * rs; acc[ai][bj][m][n] = v;
                        u32x2 w; w.x = cvt_pk_bf16(v[0], v[1]); w.y = cvt_pk_bf16(v[2], v[3]);
                        *(PG8_LAS u32x2*)(lds + j * ROWB + (bj * HALF + wc * 32 + n * 16 + fq * 4) * 2) = w; }
            }
        __syncthreads();
#pragma unroll
        for (int n = 0; n < 2; ++n) {
            const int j0 = wc * 32 + n * 16 + fq * 4, ca = u.pn * HALF + j0, cg = DFF + ca;
            if (n == 1) {
#pragma unroll
                for (int k = 0; k < 3; ++k) { wa[1][k] = *(const f32x4*)(cw + k * NUP + ca); wg[1][k] = *(const f32x4*)(cw + k * NUP + cg); }
                wa[1][3] = *(const f32x4*)(cb + ca); wg[1][3] = *(const f32x4*)(cb + cg); }
            const f32x4 wa0 = wa[n][0], wa1 = wa[n][1], wa2 = wa[n][2], ba = wa[n][3], wg0 = wg[n][0], wg1 = wg[n][1], wg2 = wg[n][2], bg = wg[n][3];
#pragma unroll
            for (int ai = 0; ai < 2; ++ai)
#pragma unroll
                for (int m = 0; m < 4; ++m) {
                    const int j = ai * HALF + wr * 64 + m * 16 + fr; const int tt = tt0 + j;
                    if (j >= 1 && j <= 254 && tt < SEQL) {
                        const u32x2 ua = *(const PG8_LAS u32x2*)(lds + (j - 1) * ROWB + j0 * 2), da = *(const PG8_LAS u32x2*)(lds + (j + 1) * ROWB + j0 * 2);
                        const u32x2 ug = *(const PG8_LAS u32x2*)(lds + (j - 1) * ROWB + (HALF + j0) * 2), dg = *(const PG8_LAS u32x2*)(lds + (j + 1) * ROWB + (HALF + j0) * 2);
                        const f32x4 upa = {__uint_as_float(ua.x << 16), __uint_as_float(ua.x & 0xffff0000u), __uint_as_float(ua.y << 16), __uint_as_float(ua.y & 0xffff0000u)};
                        const f32x4 dna = {__uint_as_float(da.x << 16), __uint_as_float(da.x & 0xffff0000u), __uint_as_float(da.y << 16), __uint_as_float(da.y & 0xffff0000u)};
                        const f32x4 upg = {__uint_as_float(ug.x << 16), __uint_as_float(ug.x & 0xffff0000u), __uint_as_float(ug.y << 16), __uint_as_float(ug.y & 0xffff0000u)};
                        const f32x4 dng = {__uint_as_float(dg.x << 16), __uint_as_float(dg.x & 0xffff0000u), __uint_as_float(dg.y << 16), __uint_as_float(dg.y & 0xffff0000u)};
                        const f32x4 a = wa0 * upa + wa1 * acc[ai][0][m][n] + wa2 * dna + ba;
                        const f32x4 g = wg0 * upg + wg1 * acc[ai][1][m][n] + wg2 * dng + bg;
                        f32x4 r;
#pragma unroll
                        for (int i = 0; i < 4; ++i) r[i] = a[i] * g[i] * __builtin_amdgcn_rcpf(1.0f + __expf(-g[i]));
                        u32x2 w; w.x = cvt_pk_bf16(r[0], r[1]); w.y = cvt_pk_bf16(r[2], r[3]);
                        *(u32x2*)(act + (size_t)(tokbase + tt) * DFF + ca) = w;
                    }
                }
        }
        __syncthreads();
    }
};
struct OneUnit {
    Unit u0;
    __device__ __forceinline__ bool next(int i, Unit& u) const { if (i != 0) return false; u = u0; return true; }
    __device__ __forceinline__ void a_ready(const Unit&) const {}
    __device__ __forceinline__ void done(const Unit&) const {}
};

template <bool SHR> __device__ __forceinline__ f32x4 dppn(const f32x4 x, const f32x4 e) { f32x4 r;
#pragma unroll
    for (int i = 0; i < 4; ++i) { const float xf = x[i], ef = e[i]; const int xi = __float_as_int(xf), ei = __float_as_int(ef);
        const int mir = __builtin_amdgcn_update_dpp(0, ei, 0x140, 0xf, 0xf, true);
        const int o = __builtin_amdgcn_update_dpp(mir, xi, SHR ? 0x111 : 0x101, 0xf, 0xf, false);
        r[i] = __int_as_float(o); }
    return r; }
struct UpOrder {
    int G, vcu;
    __device__ __forceinline__ bool next(int i, Unit& u) const { const int id = i * G + vcu; if (id >= 3 * 65 * 22) return false;
        const int mt = id / 22; u.pm = mt; u.pn = id - mt * 22; u.arow = (mt / 65) * 16384 + 254 * (mt % 65); return true; }
    __device__ __forceinline__ void a_ready(const Unit&) const {}
    __device__ __forceinline__ void done(const Unit&) const {}
};
template <bool SHR> __device__ __forceinline__ f32x4 dpps(const f32x4 x, const f32x4 old) { f32x4 r;
#pragma unroll
    for (int i = 0; i < 4; ++i) { const float xf = x[i], of = old[i];
        r[i] = __int_as_float(__builtin_amdgcn_update_dpp(__float_as_int(of), __float_as_int(xf), SHR ? 0x111 : 0x101, 0xf, 0xf, false)); }
    return r; }
struct EpiConvGate2 {
    static constexpr bool PERM = true, AFTER_DRAIN = false, APERM = true;
    bf16_t* act; const float* cw; const float* cb; PG8_LAS float* bnd; const float* ssq;
    __device__ __forceinline__ void operator()(f32x4 (&acc)[2][2][4][2], const Unit& u, int wr, int wc, int fr, int fq) const {
        constexpr int SEQL = 16384, NUP = 5632, DFF = 2816;
        typedef unsigned u32x2 __attribute__((ext_vector_type(2)));
        typedef unsigned u32x4v __attribute__((ext_vector_type(4)));
        const f32x4 zero4 = {0.f, 0.f, 0.f, 0.f};
        const int tt0 = 254 * (u.pm % 65) - 1, tokbase = (u.pm / 65) * SEQL;
        u32x2 keep[2][4];
        f32x4 wa[4], wg[4];
        { const int ca = u.pn * HALF + wc * 32 + fq * 8, cg = DFF + ca;
#pragma unroll
            for (int k = 0; k < 3; ++k) { wa[k] = *(const f32x4*)(cw + k * NUP + ca); wg[k] = *(const f32x4*)(cw + k * NUP + cg); }
            wa[3] = *(const f32x4*)(cb + ca); wg[3] = *(const f32x4*)(cb + cg); }
#pragma unroll
        for (int ai = 0; ai < 2; ++ai)
#pragma unroll
            for (int m = 0; m < 4; ++m) { const int tt = tt0 + ai * HALF + wr * 64 + 4 * fr + m; const bool valid = (unsigned)tt < (unsigned)SEQL;
                const float q = ssq[valid ? tokbase + tt : 0]; const float rs = valid ? 1.0f / sqrtf(q * (1.0f / 1024.0f) + 1e-6f) : 0.f;
#pragma unroll
                for (int bj = 0; bj < 2; ++bj)
#pragma unroll
                    for (int n = 0; n < 2; ++n) acc[ai][bj][m][n] *= rs; }
#pragma unroll
        for (int ai = 0; ai < 2; ++ai) { const int blk = ai * 2 + wr;
#pragma unroll
            for (int bj = 0; bj < 2; ++bj)
#pragma unroll
                for (int n = 0; n < 2; ++n) { const int col = bj * HALF + wc * 32 + fq * 8 + n * 4;
                    if (fr == 0) *(PG8_LAS f32x4*)(bnd + (blk * 2 + 0) * 256 + col) = acc[ai][bj][0][n];
                    if (fr == 15) *(PG8_LAS f32x4*)(bnd + (blk * 2 + 1) * 256 + col) = acc[ai][bj][3][n]; } }
        asm volatile("s_waitcnt lgkmcnt(0)" ::: "memory"); __builtin_amdgcn_s_barrier(); asm volatile("" ::: "memory");
#pragma unroll
        for (int n = 0; n < 2; ++n) {
            const int j0 = wc * 32 + fq * 8 + n * 4, ca = u.pn * HALF + j0, cg = DFF + ca;
            if (n == 1) {
#pragma unroll
                for (int k = 0; k < 3; ++k) { wa[k] = *(const f32x4*)(cw + k * NUP + ca); wg[k] = *(const f32x4*)(cw + k * NUP + cg); }
                wa[3] = *(const f32x4*)(cb + ca); wg[3] = *(const f32x4*)(cb + cg); }
#pragma unroll
            for (int ai = 0; ai < 2; ++ai) { const int blk = ai * 2 + wr;
                f32x4 upe[2], dne[2];
#pragma unroll
                for (int bj = 0; bj < 2; ++bj) { const int col = bj * HALF + j0;
                    const f32x4 abv = blk > 0 ? *(const PG8_LAS f32x4*)(bnd + ((blk - 1) * 2 + 1) * 256 + col) : zero4;
                    const f32x4 blw = blk < 3 ? *(const PG8_LAS f32x4*)(bnd + ((blk + 1) * 2 + 0) * 256 + col) : zero4;
                    upe[bj] = dpps<true>(acc[ai][bj][3][n], abv); dne[bj] = dpps<false>(acc[ai][bj][0][n], blw); }
#pragma unroll
                for (int m = 0; m < 4; ++m) {
                    const int j = ai * HALF + wr * 64 + 4 * fr + m, tt = tt0 + j;
                    f32x4 cv[2];
#pragma unroll
                    for (int bj = 0; bj < 2; ++bj) {
                        const f32x4 X = acc[ai][bj][m][n];
                        const f32x4 up = m > 0 ? acc[ai][bj][m > 0 ? m - 1 : 0][n] : upe[bj];
                        const f32x4 dn = m < 3 ? acc[ai][bj][m < 3 ? m + 1 : 3][n] : dne[bj];
                        cv[bj] = bj == 0 ? (wa[0] * up + wa[1] * X + wa[2] * dn + wa[3]) : (wg[0] * up + wg[1] * X + wg[2] * dn + wg[3]);
                    }
                    if (j >= 1 && j <= 254 && tt < SEQL) {
                        f32x4 r;
#pragma unroll
                        for (int i = 0; i < 4; ++i) r[i] = cv[0][i] * cv[1][i] * __builtin_amdgcn_rcpf(1.0f + __expf(-cv[1][i]));
                        u32x2 w; w.x = cvt_pk_bf16(r[0], r[1]); w.y = cvt_pk_bf16(r[2], r[3]);
                        if (n == 0) keep[ai][m] = w;
                        else *(u32x4v*)(act + (size_t)(tokbase + tt) * DFF + ca - 4) = (u32x4v){keep[ai][m].x, keep[ai][m].y, w.x, w.y};
                    }
                }
            }
        }
    }
};
template <class Epi, class Sched, bool ALIGN_EPI = false, bool SP2 = false>
__device__ __forceinline__ void gemm_phase(PG8_LAS unsigned char* lds, const Gemm g, const Sched& S, const Epi& E) {
    const int tid = threadIdx.x, wid = __builtin_amdgcn_readfirstlane(tid >> 6), lane = tid & 63, wr = wid >> 2, wc = wid & 3, fr = lane & 15, fq = lane >> 4;
    const int K = g.K, nt = K / BK;
    unsigned voffA[2], voffB[2];
#pragma unroll
    for (int i = 0; i < 2; ++i) { int R, C; stage_rc(tid * 16 + i * 8192, R, C); const int Rb = Epi::PERM ? ((R & ~31) + perm32(R & 31)) : R;
        const int Ra = Epi::APERM ? ((R & 64) + 4 * (R & 15) + ((R >> 4) & 3)) : R;
        voffA[i] = (unsigned)(Ra * K + C) * 2u; voffB[i] = (unsigned)(Rb * K + C) * 2u; }
    const size_t kstep = (size_t)(BK * 2);
    const size_t hstep = (size_t)HALF * K * 2;
    const size_t tstep = 2 * hstep;
    const unsigned ldsw = (unsigned)wid * 1024u;
    const int aoff = lds_byte(wr * 64 + fr, fq * 8), boff = lds_byte(wc * 32 + fr, fq * 8);
#define PG8_SA(b, h) (((b) * 2 + (h)) * HTB)
#define PG8_SB(b, h) ((4 + (b) * 2 + (h)) * HTB)
#define PG8_STAGE(bufoff, gbase, voff) do { _Pragma("unroll") for (int _i = 0; _i < 2; ++_i) \
        __builtin_amdgcn_global_load_lds((const unsigned*)((const char*)(gbase) + (voff)[_i]), (PG8_LAS unsigned*)(lds + (bufoff) + ldsw + _i * 8192), 16, 0, 0); } while (0)
#define PG8_LDA(dst, b, h) do { _Pragma("unroll") for (int m = 0; m < 4; ++m) _Pragma("unroll") for (int k = 0; k < 2; ++k) dst[m][k] = *(const PG8_LAS bf16x8*)(lds + PG8_SA(b, h) + aoff + m * 2048 + k * 1024); } while (0)
#define PG8_LDB(dst, b, h) do { _Pragma("unroll") for (int n = 0; n < 2; ++n) _Pragma("unroll") for (int k = 0; k < 2; ++k) dst[n][k] = *(const PG8_LAS bf16x8*)(lds + PG8_SB(b, h) + boff + n * 2048 + k * 1024); } while (0)
#define PG8_MMA(ai, bj, At, Bt) do { __builtin_amdgcn_s_setprio(1); _Pragma("unroll") for (int m = 0; m < 4; ++m) _Pragma("unroll") for (int n = 0; n < 2; ++n) _Pragma("unroll") for (int k = 0; k < 2; ++k) \
        acc[ai][bj][m][n] = __builtin_amdgcn_mfma_f32_16x16x32_bf16(Bt[n][k], At[m][k], acc[ai][bj][m][n], 0, 0, 0); __builtin_amdgcn_s_setprio(0); } while (0)
#define PG8_WAIT_V(n) asm volatile("s_waitcnt vmcnt(" #n ")" ::: "memory")
#define PG8_WAIT_L(n) asm volatile("s_waitcnt lgkmcnt(" #n ")" ::: "memory")
#define PG8_BAR __builtin_amdgcn_s_barrier()
#define PG8_SCHED __builtin_amdgcn_sched_barrier(0)
    Unit cur, nxt; int ui = 0;
    if (!S.next(0, cur)) return;
    f32x4 acc[2][2][4][2];
#pragma unroll
    for (int a = 0; a < 2; ++a)
#pragma unroll
        for (int b = 0; b < 2; ++b)
#pragma unroll
            for (int m = 0; m < 4; ++m)
#pragma unroll
                for (int n = 0; n < 2; ++n) acc[a][b][m][n] = (f32x4){0.f, 0.f, 0.f, 0.f};
    bf16x8 At[4][2], B0[2][2], B1[2][2];
    const char* cA = (const char*)g.A + (size_t)cur.arow * (size_t)K * 2; const char* cB = (const char*)g.Bt + (size_t)cur.pn * tstep;
    S.a_ready(cur);
    if constexpr (SP2) {
        PG8_STAGE(PG8_SB(0, 0), cB, voffB); PG8_STAGE(PG8_SB(0, 1), cB + hstep, voffB); PG8_STAGE(PG8_SA(0, 0), cA, voffA); PG8_STAGE(PG8_SA(0, 1), cA + hstep, voffA);
        if (wr == 1) PG8_BAR;
        PG8_WAIT_V(2); PG8_BAR;
        PG8_STAGE(PG8_SB(1, 0), cB + kstep, voffB); PG8_STAGE(PG8_SA(1, 0), cA + kstep, voffA); PG8_STAGE(PG8_SB(1, 1), cB + hstep + kstep, voffB);
        PG8_WAIT_V(6); PG8_BAR;
    } else {
        PG8_STAGE(PG8_SB(0, 0), cB, voffB); PG8_STAGE(PG8_SA(0, 0), cA, voffA); PG8_STAGE(PG8_SB(0, 1), cB + hstep, voffB); PG8_STAGE(PG8_SA(0, 1), cA + hstep, voffA);
        if (wr == 1) PG8_BAR;
        PG8_WAIT_V(4); PG8_BAR;
        PG8_STAGE(PG8_SB(1, 0), cB + kstep, voffB); PG8_STAGE(PG8_SA(1, 0), cA + kstep, voffA); PG8_STAGE(PG8_SB(1, 1), cB + hstep + kstep, voffB);
        PG8_WAIT_V(6); PG8_BAR;
    }
    for (;;) {
        const bool has_next = S.next(ui + 1, nxt);
        const char* nA = has_next ? (const char*)g.A + (size_t)nxt.arow * (size_t)K * 2 : cA; const char* nB = has_next ? (const char*)g.Bt + (size_t)nxt.pn * tstep : cB;
        for (int t = 0; t < nt; t += 2) {
            const bool last = (t == nt - 2);
            const char* a1 = cA + (size_t)(t + 1) * kstep;
            const char* a2 = last ? nA : cA + (size_t)(t + 2) * kstep; const char* b2 = last ? nB : cB + (size_t)(t + 2) * kstep;
            const char* a3 = a2 + kstep; const char* b3 = b2 + kstep;
            if (last && has_next) S.a_ready(nxt);
            if constexpr (SP2) {
            PG8_LDB(B0, 0, 0); PG8_LDB(B1, 0, 1); PG8_SCHED; PG8_LDA(At, 0, 0); PG8_STAGE(PG8_SA(1, 1), a1 + hstep, voffA);
            PG8_WAIT_V(8); PG8_WAIT_L(0); PG8_BAR; PG8_MMA(0, 0, At, B0); PG8_MMA(0, 1, At, B1); PG8_BAR; PG8_SCHED;
            PG8_LDA(At, 0, 1); PG8_STAGE(PG8_SB(0, 0), b2, voffB); PG8_STAGE(PG8_SB(0, 1), b2 + hstep, voffB); PG8_STAGE(PG8_SA(0, 0), a2, voffA);
            PG8_WAIT_V(8); PG8_WAIT_L(0); PG8_BAR; PG8_MMA(1, 0, At, B0); PG8_MMA(1, 1, At, B1); PG8_BAR; PG8_SCHED;
            PG8_LDB(B0, 1, 0); PG8_LDB(B1, 1, 1); PG8_SCHED; PG8_LDA(At, 1, 0); PG8_STAGE(PG8_SA(0, 1), a2 + hstep, voffA);
            PG8_WAIT_V(8); PG8_WAIT_L(0); PG8_BAR; PG8_MMA(0, 0, At, B0); PG8_MMA(0, 1, At, B1); PG8_BAR; PG8_SCHED;
            PG8_LDA(At, 1, 1); PG8_STAGE(PG8_SB(1, 0), b3, voffB); PG8_STAGE(PG8_SB(1, 1), b3 + hstep, voffB); PG8_STAGE(PG8_SA(1, 0), a3, voffA);
            PG8_WAIT_V(8); PG8_WAIT_L(0); PG8_BAR; PG8_MMA(1, 0, At, B0); PG8_MMA(1, 1, At, B1); PG8_BAR; PG8_SCHED;
            } else {
            PG8_LDB(B0, 0, 0); PG8_SCHED; PG8_LDA(At, 0, 0); PG8_STAGE(PG8_SA(1, 1), a1 + hstep, voffA);
            PG8_WAIT_L(8); PG8_BAR; PG8_WAIT_L(0); PG8_MMA(0, 0, At, B0); PG8_BAR; PG8_SCHED;
            PG8_LDB(B1, 0, 1); PG8_STAGE(PG8_SB(0, 0), b2, voffB);
            PG8_BAR; PG8_WAIT_L(0); PG8_MMA(0, 1, At, B1); PG8_BAR;
            PG8_LDA(At, 0, 1); PG8_STAGE(PG8_SA(0, 0), a2, voffA);
            PG8_BAR; PG8_WAIT_L(0); PG8_MMA(1, 0, At, B0); PG8_BAR; PG8_SCHED;
            PG8_STAGE(PG8_SB(0, 1), b2 + hstep, voffB);
            PG8_WAIT_V(6); PG8_BAR; PG8_MMA(1, 1, At, B1); PG8_BAR;
            PG8_LDB(B0, 1, 0); PG8_SCHED; PG8_LDA(At, 1, 0); PG8_STAGE(PG8_SA(0, 1), a2 + hstep, voffA);
            PG8_WAIT_L(8); PG8_BAR; PG8_WAIT_L(0); PG8_MMA(0, 0, At, B0); PG8_BAR; PG8_SCHED;
            PG8_LDB(B1, 1, 1); PG8_STAGE(PG8_SB(1, 0), b3, voffB);
            PG8_BAR; PG8_WAIT_L(0); PG8_MMA(0, 1, At, B1); PG8_BAR;
            PG8_LDA(At, 1, 1); PG8_STAGE(PG8_SA(1, 0), a3, voffA);
            PG8_BAR; PG8_WAIT_L(0); PG8_MMA(1, 0, At, B0); PG8_BAR; PG8_SCHED;
            PG8_STAGE(PG8_SB(1, 1), b3 + hstep, voffB);
            PG8_WAIT_V(6); PG8_BAR; PG8_MMA(1, 1, At, B1); PG8_BAR;
            }
        }
        if constexpr (ALIGN_EPI) { if (wr == 0) PG8_BAR; }
        if constexpr (!Epi::AFTER_DRAIN) { E(acc, cur, wr, wc, fr, fq); S.done(cur); }
        if (!has_next) break;
#pragma unroll
        for (int a = 0; a < 2; ++a)
#pragma unroll
            for (int b = 0; b < 2; ++b)
#pragma unroll
                for (int m = 0; m < 4; ++m)
#pragma unroll
                    for (int n = 0; n < 2; ++n) acc[a][b][m][n] = (f32x4){0.f, 0.f, 0.f, 0.f};
        cur = nxt; cA = nA; cB = nB; ++ui;
        if constexpr (ALIGN_EPI) { if (wr == 1) PG8_BAR; }
    }
    PG8_WAIT_V(0);
    if constexpr (!ALIGN_EPI) { if (wr == 0) PG8_BAR; }
    PG8_BAR;
    if constexpr (Epi::AFTER_DRAIN) { E.fused(acc, cur, wr, wc, fr, fq, lds, wid, lane); S.done(cur); }
#undef PG8_SA
#undef PG8_SB
#undef PG8_STAGE
#undef PG8_LDA
#undef PG8_LDB
#undef PG8_MMA
#undef PG8_WAIT_V
#undef PG8_WAIT_L
#undef PG8_BAR
#undef PG8_SCHED
}
}
#include <hip/hip_bf16.h>
#include <cmath>
namespace attn_body {
using bf16=__hip_bfloat16;
using bf16x8=__attribute__((ext_vector_type(8)))short;
using s16x4=__attribute__((ext_vector_type(4)))short;
using f32x16=__attribute__((ext_vector_type(16)))float;
using u32x4=__attribute__((ext_vector_type(4)))unsigned;
constexpr int SEQ=16384,D=64,DM=2560,OPITCH=1024;
constexpr int NW=8,QBLK=32,QB=QBLK*NW,KVBLK=64,NQB=SEQ/QB;
constexpr int ATTN_UNIT_ROWS=QB;
__device__ __forceinline__ int crow(int r,int hi){return (r&3)+8*(r>>2)+4*hi;}
#define SBAR() __builtin_amdgcn_sched_barrier(0)
__device__ __forceinline__ void cmask(f32x16&p0,f32x16&p1,int jb,int qrel,int hi){
  const float NEG=-INFINITY; int kb=64*jb+4*hi;
  #pragma unroll
  for(int r=0;r<16;++r){int kv=kb+(r&3)+8*(r>>2); if(kv>qrel)p0[r]=NEG; if(kv+32>qrel)p1[r]=NEG;}
}

constexpr int NSLOT=3, SLOTB=8192;
constexpr int LDS_K=0, LDS_V=NSLOT*SLOTB, LDS_WS=2*NSLOT*SLOTB, LDS_OST=LDS_WS+NW*64*4, LDS_BYTES=LDS_OST+NW*4096;
constexpr float C2=0.125f*1.4426950408889634f;
__device__ __forceinline__ void glds16(const void*gsrc,unsigned lds_dst){unsigned keep;
  asm volatile("s_mov_b32 %0, m0\n\ts_mov_b32 m0, %2\n\ts_nop 0\n\tglobal_load_lds_dwordx4 %1, off\n\ts_mov_b32 m0, %0":"=&s"(keep):"v"(gsrc),"s"(lds_dst):"memory");}
__device__ __forceinline__ float max3f(float a,float b,float c){float r;asm("v_max3_f32 %0, %1, %2, %3":"=v"(r):"v"(a),"v"(b),"v"(c));return r;}
__device__ __forceinline__ float max2f(float a,float b){float r;asm("v_max_f32_e32 %0, %1, %2":"=v"(r):"v"(a),"v"(b));return r;}
__device__ __forceinline__ float fadd_s(float a,float b){float r;asm("v_add_f32_e32 %0, %1, %2":"=v"(r):"v"(a),"v"(b));return r;}
__device__ __forceinline__ float fsub_s(float a,float b){float r;asm("v_sub_f32_e32 %0, %1, %2":"=v"(r):"v"(a),"v"(b));return r;}
typedef float f32x2_t __attribute__((ext_vector_type(2))); typedef __bf16 bf16x2_t __attribute__((ext_vector_type(2)));
__device__ __forceinline__ unsigned cvtpk_s(float lo,float hi){f32x2_t v={lo,hi};bf16x2_t b=__builtin_convertvector(v,bf16x2_t);return __builtin_bit_cast(unsigned,b);}
#define WAIT_BAR(N) asm volatile("s_waitcnt vmcnt(" #N ") lgkmcnt(0)\n\ts_barrier":::"memory")

__device__ __forceinline__ void qkt(f32x16&p0,f32x16&p1,const char*Kslot,const bf16x8*qr,const f32x16&negm,int r32,int hi){
  const char*kb=Kslot+hi*1024+r32*16;
  #pragma unroll
  for(int d0=0;d0<4;++d0){
    const bf16x8 b0=*reinterpret_cast<const bf16x8*>(kb+d0*2048);
    const bf16x8 b1=*reinterpret_cast<const bf16x8*>(kb+d0*2048+512);
    if(d0==0){p0=__builtin_amdgcn_mfma_f32_32x32x16_bf16(b0,qr[0],negm,0,0,0);p1=__builtin_amdgcn_mfma_f32_32x32x16_bf16(b1,qr[0],negm,0,0,0);}
    else{p0=__builtin_amdgcn_mfma_f32_32x32x16_bf16(b0,qr[d0],p0,0,0,0);p1=__builtin_amdgcn_mfma_f32_32x32x16_bf16(b1,qr[d0],p1,0,0,0);}}
}
typedef __attribute__((address_space(3))) const char* lds_cptr;
typedef short v4i16_t __attribute__((ext_vector_type(4)));
__device__ __forceinline__ void kload8(bf16x8*kf,lds_cptr kp){
  kf[0]=*(const __attribute__((address_space(3))) bf16x8*)(kp);      kf[1]=*(const __attribute__((address_space(3))) bf16x8*)(kp+512);
  kf[2]=*(const __attribute__((address_space(3))) bf16x8*)(kp+2048); kf[3]=*(const __attribute__((address_space(3))) bf16x8*)(kp+2560);
  kf[4]=*(const __attribute__((address_space(3))) bf16x8*)(kp+4096); kf[5]=*(const __attribute__((address_space(3))) bf16x8*)(kp+4608);
  kf[6]=*(const __attribute__((address_space(3))) bf16x8*)(kp+6144); kf[7]=*(const __attribute__((address_space(3))) bf16x8*)(kp+6656);
}
__device__ __forceinline__ void kload2(bf16x8*kf,lds_cptr kp,int j){ kf[2*j]=*(const __attribute__((address_space(3))) bf16x8*)(kp+j*2048); kf[2*j+1]=*(const __attribute__((address_space(3))) bf16x8*)(kp+j*2048+512); }
__device__ __forceinline__ s16x4 vtr(lds_cptr p){ return __builtin_bit_cast(s16x4,__builtin_amdgcn_ds_read_tr16_b64_v4i16((__attribute__((address_space(3))) v4i16_t*)p)); }
__device__ __forceinline__ float rowmax(const f32x16&p0,const f32x16&p1){
  float a=max3f(p0[0],p0[1],p1[0]),b=max3f(p0[2],p0[3],p1[1]);a=max3f(a,p1[2],p1[3]);
  #pragma unroll
  for(int r=4;r<16;r+=4){a=max3f(a,p0[r],p0[r+1]);b=max3f(b,p0[r+2],p0[r+3]);a=max3f(a,p1[r],p1[r+1]);b=max3f(b,p1[r+2],p1[r+3]);}
  const float m=max2f(a,b);
  auto rr=__builtin_amdgcn_permlane32_swap(__float_as_uint(m),__float_as_uint(m),false,false);
  return max2f(__uint_as_float(rr[0]),__uint_as_float(rr[1]));
}
__device__ __forceinline__ void pv(f32x16*o,int vb,bf16x8 pa0,bf16x8 pa1,bf16x8 pa2,bf16x8 pa3){
  #pragma unroll
  for(int d0=0;d0<2;++d0){s16x4 lo[4],hi[4];
    #pragma unroll
    for(int ks=0;ks<4;++ks){
      asm volatile("ds_read_b64_tr_b16 %0,%1 offset:%c2":"=&v"(lo[ks]):"v"(vb),"i"(d0*4096+ks*1024):"memory");
      asm volatile("ds_read_b64_tr_b16 %0,%1 offset:%c2":"=&v"(hi[ks]):"v"(vb),"i"(d0*4096+ks*1024+512):"memory");}
    asm volatile("s_waitcnt lgkmcnt(0)":::"memory");SBAR();
    #define PK(k) (bf16x8){lo[k][0],lo[k][1],lo[k][2],lo[k][3],hi[k][0],hi[k][1],hi[k][2],hi[k][3]}
    o[d0]=__builtin_amdgcn_mfma_f32_32x32x16_bf16(pa0,PK(0),o[d0],0,0,0);
    o[d0]=__builtin_amdgcn_mfma_f32_32x32x16_bf16(pa1,PK(1),o[d0],0,0,0);
    o[d0]=__builtin_amdgcn_mfma_f32_32x32x16_bf16(pa2,PK(2),o[d0],0,0,0);
    o[d0]=__builtin_amdgcn_mfma_f32_32x32x16_bf16(pa3,PK(3),o[d0],0,0,0);
    #undef PK
  }
}

#ifndef ATTN_STORE16
#define ATTN_STORE16(p,v) (*(u32x4*)(p)=(v))
#endif
template<int THRL> __device__ __forceinline__ void attn_unit(int qb,const bf16*Qp,const bf16*__restrict__ Kh,const bf16*__restrict__ Vh,bf16*Op,char*shm,const float mfix){
  const int tid=threadIdx.x,lane=tid&63,r32=lane&31,hi=lane>>5; const int wid=__builtin_amdgcn_readfirstlane(tid>>6);
  const int q0=qb*QB;
  const bf16*Qw=Qp+(long)(q0+wid*QBLK)*DM;
  const unsigned lds0=(unsigned)(uintptr_t)shm;
  float*wsf=(float*)(shm+LDS_WS)+wid*64;
  const bf16*ksrc=Kh+(long)lane*DM+wid*8;
  const bf16*vsrc=Vh+(long)(16*(wid&3)+(lane>>2))*DM+(wid>>2)*32+(lane&3)*8;
  const unsigned kdst=lds0+LDS_K+wid*1024, vdst=lds0+LDS_V+wid*1024;
  #define DMA_K(t,slot) glds16(ksrc+(long)(t)*KVBLK*DM,(unsigned)__builtin_amdgcn_readfirstlane(kdst+(slot)))
  #define DMA_V(t,slot) glds16(vsrc+(long)(t)*KVBLK*DM,(unsigned)__builtin_amdgcn_readfirstlane(vdst+(slot)))
  const int vb0=(int)(lds0+LDS_V)+((lane>>4)&1)*32+(lane&3)*8+(4*hi+((lane&15)>>2))*64;
  const char*Kbase=shm+LDS_K; bf16x8 kf[8];
  const lds_cptr shm3=(lds_cptr)shm; const lds_cptr kp0=shm3+LDS_K+hi*1024+r32*16; const lds_cptr vp0=shm3+LDS_V+((lane>>4)&1)*32+(lane&3)*8+(4*hi+((lane&15)>>2))*64;
  constexpr int NT=SEQ/KVBLK;
  DMA_K(0,0);DMA_V(0,0);DMA_K(1,SLOTB);
  bf16x8 qr[4];
  #pragma unroll
  for(int d0=0;d0<4;++d0)qr[d0]=*reinterpret_cast<const bf16x8*>(&Qw[(long)r32*DM+d0*16+hi*8]);
  float l_reg=0.f;f32x16 o[2];o[0]=f32x16{};o[1]=f32x16{};f32x16 negm;
  _Pragma("unroll") for(int r=0;r<16;++r)negm[r]=-mfix; asm volatile("":"+v"(negm));
  const int qrel=wid*QBLK+r32;
  #define CMASK(P0,P1,t) do{}while(0)
  #define START(P0,P1) do{ _Pragma("unroll") for(int r=0;r<16;++r)P0[r]=__builtin_amdgcn_exp2f(P0[r]); }while(0)
  #define RESC() do{}while(0)
  f32x16 pA0,pA1,pB0,pB1;
  int sl_prev=0,sl_cur=0,sl_next=SLOTB;
  #define ROT() do{sl_prev=sl_cur;sl_cur=sl_next;sl_next=(sl_next==(NSLOT-1)*SLOTB)?0:sl_next+SLOTB;}while(0)
  DMA_K(2,2*SLOTB);
  WAIT_BAR(3);
  qkt(pA0,pA1,Kbase,qr,negm,r32,hi);asm volatile("s_nop 15\n\ts_nop 7":"+v"(pA0),"+v"(pA1));CMASK(pA0,pA1,0);
  START(pA0,pA1);
  _Pragma("unroll") for(int r=0;r<16;++r)pA1[r]=__builtin_amdgcn_exp2f(pA1[r]);
  WAIT_BAR(0);
  DMA_K(3,0);DMA_V(1,SLOTB);
  ROT();
  kload8(kf,kp0+sl_cur);
  WAIT_BAR(2);
  s16x4 vlo[8],vhi[8]; u32x4 pw0,pw1,pw2,pw3;
  #define PKW(P,B) cvtpk_s(P[B],P[B+1])
  #define PAF(k) __builtin_bit_cast(bf16x8,pw##k)
  #define VFR(i) (bf16x8){vlo[i][0],vlo[i][1],vlo[i][2],vlo[i][3],vhi[i][0],vhi[i][1],vhi[i][2],vhi[i][3]}
  #define PIN(x) asm volatile("":"+v"(x))
  #define MX3(a,b,c) __builtin_fmaxf(__builtin_fmaxf((a),(b)),(c))
  #define GAPA(MF,A0,A1,A2,A3,W0,W1,PW) do{ MF; sacc+=A0; sacc+=A1; sacc+=A2; sacc+=A3; PIN(sacc); W0; W1; PIN(PW); SBAR(); }while(0)
  #define EX(v) __builtin_amdgcn_exp2f(v)
  #define GAPB(MF,X,B) do{ MF; X[B]=EX(X[B]); X[B+1]=EX(X[B+1]); X[B+2]=EX(X[B+2]); X[B+3]=EX(X[B+3]); PIN(X); SBAR(); }while(0)
  #define VRD(i) do{ vlo[i]=vtr(vp_+(((i)>>2)*4096+((i)&3)*1024)); vhi[i]=vtr(vp_+(((i)>>2)*4096+((i)&3)*1024+512)); }while(0)
  #define KRD(G,j) do{ if(G){ kload2(kf,kp0+sl_next,j); SBAR(); } }while(0)
  #define STEP(C0,C1,P0,P1,t,GK,GV,GL) do{ SBAR(); \
    const lds_cptr vp_=vp0+sl_prev; \
    VRD(0); SBAR(); float sacc=(P0[0]+P0[1]); \
    GAPA(C0=__builtin_amdgcn_mfma_f32_32x32x16_bf16(kf[0],qr[0],negm,0,0,0), P0[2],P0[3],P0[4],P0[5],     pw0[0]=PKW(P0,0), pw0[1]=PKW(P0,2), pw0); \
    VRD(4); SBAR(); GAPA(C1=__builtin_amdgcn_mfma_f32_32x32x16_bf16(kf[1],qr[0],negm,0,0,0), P0[6],P0[7],P0[8],P0[9],     pw0[2]=PKW(P0,4), pw0[3]=PKW(P0,6), pw0); \
    VRD(1); SBAR(); GAPA(C0=__builtin_amdgcn_mfma_f32_32x32x16_bf16(kf[2],qr[1],C0,0,0,0),   P0[10],P0[11],P0[12],P0[13], pw1[0]=PKW(P0,8), pw1[1]=PKW(P0,10), pw1); \
    VRD(5); SBAR(); GAPA(C1=__builtin_amdgcn_mfma_f32_32x32x16_bf16(kf[3],qr[1],C1,0,0,0),   P0[14],P0[15],P1[0],P1[1],   pw1[2]=PKW(P0,12),pw1[3]=PKW(P0,14), pw1); \
    VRD(2); SBAR(); GAPA(C0=__builtin_amdgcn_mfma_f32_32x32x16_bf16(kf[4],qr[2],C0,0,0,0),   P1[2],P1[3],P1[4],P1[5],     pw2[0]=PKW(P1,0), pw2[1]=PKW(P1,2), pw2); \
    VRD(6); SBAR(); GAPA(C1=__builtin_amdgcn_mfma_f32_32x32x16_bf16(kf[5],qr[2],C1,0,0,0),   P1[6],P1[7],P1[8],P1[9],     pw2[2]=PKW(P1,4), pw2[3]=PKW(P1,6), pw2); \
    VRD(3); SBAR(); GAPA(C0=__builtin_amdgcn_mfma_f32_32x32x16_bf16(kf[6],qr[3],C0,0,0,0),   P1[10],P1[11],P1[12],P1[13], pw3[0]=PKW(P1,8), pw3[1]=PKW(P1,10), pw3); \
    VRD(7); SBAR(); GAPA(C1=__builtin_amdgcn_mfma_f32_32x32x16_bf16(kf[7],qr[3],C1,0,0,0),   P1[14],P1[15],0.f,0.f,       pw3[2]=PKW(P1,12),pw3[3]=PKW(P1,14), pw3); \
    l_reg+=sacc; \
    if(GK){DMA_K((t)+3,sl_cur);} if(GV){DMA_V((t)+1,sl_next);} \
    CMASK(C0,C1,t); \
    SBAR(); \
    GAPB(o[0]=__builtin_amdgcn_mfma_f32_32x32x16_bf16(PAF(0),VFR(0),o[0],0,0,0), C0,0); \
    GAPB(o[1]=__builtin_amdgcn_mfma_f32_32x32x16_bf16(PAF(0),VFR(4),o[1],0,0,0), C0,4); \
    KRD(GL,0); GAPB(o[0]=__builtin_amdgcn_mfma_f32_32x32x16_bf16(PAF(1),VFR(1),o[0],0,0,0), C0,8); \
    KRD(GL,1); GAPB(o[1]=__builtin_amdgcn_mfma_f32_32x32x16_bf16(PAF(1),VFR(5),o[1],0,0,0), C0,12); \
    KRD(GL,2); GAPB(o[0]=__builtin_amdgcn_mfma_f32_32x32x16_bf16(PAF(2),VFR(2),o[0],0,0,0), C1,0); \
    KRD(GL,3); GAPB(o[1]=__builtin_amdgcn_mfma_f32_32x32x16_bf16(PAF(2),VFR(6),o[1],0,0,0), C1,4); \
    GAPB(o[0]=__builtin_amdgcn_mfma_f32_32x32x16_bf16(PAF(3),VFR(3),o[0],0,0,0), C1,8); \
    GAPB(o[1]=__builtin_amdgcn_mfma_f32_32x32x16_bf16(PAF(3),VFR(7),o[1],0,0,0), C1,12); \
    }while(0)
  int t=1;
  #undef CMASK
  #define CMASK(P0,P1,t) do{}while(0)
  for(;t+5<NT;t+=2){
    STEP(pB0,pB1,pA0,pA1,t,true,true,true);     WAIT_BAR(2); RESC(); ROT();
    STEP(pA0,pA1,pB0,pB1,t+1,true,true,true);   WAIT_BAR(2); RESC(); ROT();
  }
  #undef CMASK
  #define CMASK(P0,P1,t) do{}while(0)
  #define ENDW(tt) do{ if((tt)+3<NT){WAIT_BAR(2);} else if((tt)+2<NT){WAIT_BAR(1);} else {WAIT_BAR(0);} }while(0)
  for(;t+1<NT;t+=2){
    STEP(pB0,pB1,pA0,pA1,t,(t+3<NT),(t+1<NT),(t+1<NT));       ENDW(t);   RESC(); ROT();
    STEP(pA0,pA1,pB0,pB1,t+1,(t+4<NT),(t+2<NT),(t+2<NT));     ENDW(t+1); RESC(); ROT();
  }
  STEP(pB0,pB1,pA0,pA1,NT-1,false,false,false); RESC();
  { float sacc=pB0[0]+pB0[1]; _Pragma("unroll") for(int r=2;r<16;++r)sacc+=pB0[r]; _Pragma("unroll") for(int r=0;r<16;++r)sacc+=pB1[r]; l_reg+=sacc;
    pw0=(u32x4){PKW(pB0,0),PKW(pB0,2),PKW(pB0,4),PKW(pB0,6)};pw1=(u32x4){PKW(pB0,8),PKW(pB0,10),PKW(pB0,12),PKW(pB0,14)};pw2=(u32x4){PKW(pB1,0),PKW(pB1,2),PKW(pB1,4),PKW(pB1,6)};pw3=(u32x4){PKW(pB1,8),PKW(pB1,10),PKW(pB1,12),PKW(pB1,14)};
    SBAR(); pv(o,vb0+sl_cur,PAF(0),PAF(1),PAF(2),PAF(3)); }
  #undef PKW
  #undef PAF
  #undef VFR
  #undef PIN
  #undef MX3
  #undef GAPA
  #undef GAPB
  #undef EX
  #undef VRD
  #undef KRD
  #undef STEP
  #undef ENDW
  {auto rr=__builtin_amdgcn_permlane32_swap(__float_as_uint(l_reg),__float_as_uint(l_reg),false,false);l_reg=__uint_as_float(rr[0])+__uint_as_float(rr[1]);}
  if(hi==0)wsf[32+r32]=l_reg;asm volatile("s_waitcnt lgkmcnt(0)":::"memory");
  float rli[16];
  #pragma unroll
  for(int r=0;r<16;++r)rli[r]=__builtin_amdgcn_rcpf(wsf[32+crow(r,hi)]);
  bf16*Ow=Op+(long)(q0+wid*QBLK)*OPITCH;
  { bf16*stg=(bf16*)(shm+LDS_OST)+wid*2048;
    #pragma unroll
    for(int r=0;r<16;++r){const int orow=crow(r,hi);
      #pragma unroll
      for(int d0=0;d0<2;++d0)stg[orow*64+d0*32+r32]=__float2bfloat16(o[d0][r]*rli[r]);}
    asm volatile("s_waitcnt lgkmcnt(0)":::"memory");
    #pragma unroll
    for(int i=0;i<4;++i){const int row=i*8+(lane>>3),ch=lane&7; const u32x4 v=*(const u32x4*)(stg+row*64+ch*8); ATTN_STORE16(Ow+(long)row*OPITCH+ch*8,v);} }
  asm volatile("s_waitcnt lgkmcnt(0)\n\ts_barrier":::"memory");
  #undef DMA_K
  #undef DMA_V
  #undef CMASK
  #undef START
  #undef RESC
  #undef ROT
}
constexpr int ATTN_LDS_BYTES=LDS_BYTES;
#undef SBAR
#undef WAIT_BAR
}
#include <hip/hip_cooperative_groups.h>
namespace cg = cooperative_groups;
#ifndef REP_P0
#define REP_P0 1
#endif
#ifndef REP_P9
#define REP_P9 1
#endif
#ifndef REP_ATT
#define REP_ATT 1
#endif
#ifndef REP_G3
#define REP_G3 1
#endif
#ifndef REP_G1
#define REP_G1 1
#endif
#ifndef REP_P7
#define REP_P7 1
#endif
#ifndef P7_PIPE
#define P7_PIPE 1
#endif
#ifndef MK_CMP7
#define MK_CMP7 0
#endif
#ifndef MK_DIAG
#define MK_DIAG 0
#endif
#ifndef MK_PER_PHASE
#define MK_PER_PHASE 0
#endif
constexpr int NWAVES = 8, NTHR = 512;
constexpr int SEQL = 16384, NSEQ = 3, TOK = NSEQ * SEQL, DMODEL = 1024, NPROJ = 2560, DFF = 2816, NUP = 5632, INW = 2336;
constexpr int NCHUNK = SEQL / 64, NITEM = NSEQ * 4 * NCHUNK;
constexpr float RMS_EPS = 1e-6f;
constexpr int C_GQ = 0, C_GK = 256, C_GV = 512, C_GG = 1024, C_AQ = 1536, C_AK = 2048, C_AV = 2176, C_RF = 2304;
constexpr size_t MiB = 1u << 20;
constexpr size_t WS_WIN = 0, WS_WOUT = 5 * MiB, WS_WUP = 7 * MiB, WS_WDN = 18 * MiB, WS_ROPE = 24 * MiB, WS_DEC = 24 * MiB + 65536;
constexpr size_t WS_H = 26 * MiB;
constexpr size_t WS_A = 124 * MiB;
constexpr size_t WS_S = 364 * MiB;
constexpr size_t WS_H2 = 388 * MiB;
constexpr size_t WS_SSQ2 = 23 * MiB + 512 * 1024;
constexpr size_t WS_SSQ = 25 * MiB + 640 * 1024;
constexpr size_t WS_END = 485 * MiB;
constexpr int LDS_BYTES = 147456;
typedef unsigned short bf16_t;
typedef float f32x4 __attribute__((ext_vector_type(4)));
typedef float f32x16 __attribute__((ext_vector_type(16)));
typedef short bf16x8 __attribute__((ext_vector_type(8)));
typedef unsigned u32x4 __attribute__((ext_vector_type(4)));
typedef unsigned u32x2 __attribute__((ext_vector_type(2)));
#define LAS __attribute__((address_space(3)))
#define DI __device__ __forceinline__

DI unsigned pk2(float lo, float hi) { return pg8::cvt_pk_bf16(lo, hi); }
DI float bflo(unsigned w) { return __uint_as_float(w << 16); }
DI float bfhi(unsigned w) { return __uint_as_float(w & 0xffff0000u); }
DI unsigned short f2bf(float f) { return (unsigned short)(pk2(f, 0.f) & 0xffffu); }
DI float wave_sum(float v) {
#pragma unroll
    for (int o = 1; o < 64; o <<= 1) v += __shfl_xor(v, o);
    return v;
}
DI int crow16(int r, int hi) { return (r & 3) + 8 * (r >> 2) + 4 * hi; }

#define XB_TMO      128
#define XB_XCNT(j)  (256  + 64 * (j))
#define XB_XSUB(j)  (1280 + 64 * (j))
#define XB_XGEN(j)  (2304 + 64 * (j))
#define XB_TOP      3328
#define XB_TOPGEN   3392
#define XCD_BAR_WORDS 3456
#define XB_SPIN_CAP (1u << 18)

__device__ __forceinline__ unsigned xb_ld(unsigned* p)              { return __hip_atomic_load(p, __ATOMIC_RELAXED, __HIP_MEMORY_SCOPE_AGENT); }
__device__ __forceinline__ unsigned xb_add(unsigned* p, unsigned v) { return __hip_atomic_fetch_add(p, v, __ATOMIC_RELAXED, __HIP_MEMORY_SCOPE_AGENT); }
__device__ __forceinline__ unsigned xb_xcc_id() { return (unsigned)__builtin_amdgcn_s_getreg((3 << 11) | 20) & 0xFu; }
#define XB_SPIN(cond, bar) do { unsigned _sp = 0; while (cond) { __builtin_amdgcn_s_sleep(1); \
    if ((++_sp & 255u) == 0u) { if (xb_ld(&(bar)[XB_TMO])) break; if (_sp > XB_SPIN_CAP) { atomicAdd(&(bar)[XB_TMO], 1u); break; } } } } while (0)

struct XcdBarrier {
    unsigned* bar; unsigned x;
    volatile LAS unsigned* st;
};

__device__ __forceinline__ XcdBarrier xcd_barrier_post(unsigned* bar, volatile LAS unsigned* st) {
    XcdBarrier b; b.bar = bar; b.x = xb_xcc_id(); b.st = st;
    if (threadIdx.x == 0) (void)xb_add(&bar[XB_XCNT(b.x)], 1u);
    return b;
}
__device__ __forceinline__ void xcd_barrier_complete(unsigned* bar, unsigned x, unsigned& nloc, unsigned& nx) {
    const unsigned G = gridDim.x * gridDim.y * gridDim.z;
    unsigned sum, cnt, mine, sp = 0u;
    for (;;) {
        sum = 0u; cnt = 0u; mine = 0u;
#pragma unroll
        for (unsigned j = 0; j < 16; ++j) { const unsigned c = xb_ld(&bar[XB_XCNT(j)]); sum += c; cnt += (c > 0u) ? 1u : 0u; mine = (j == x) ? c : mine; }
        if (sum == G) break;
        __builtin_amdgcn_s_sleep(1);
        if ((++sp & 255u) == 0u) { if (xb_ld(&bar[XB_TMO])) break; if (sp > XB_SPIN_CAP) { atomicAdd(&bar[XB_TMO], 1u); break; } }
    }
    nloc = mine > 0u ? mine : 1u; nx = cnt > 0u ? cnt : 1u;
}

__device__ __forceinline__ void xcd_barrier(const XcdBarrier& b) {
    asm volatile("s_waitcnt vmcnt(0)" ::: "memory");
    __syncthreads();
    if (threadIdx.x == 0) {
        unsigned* bar = b.bar;
        __builtin_amdgcn_s_waitcnt(0);
        unsigned nloc = b.st[0], nx = b.st[1];
        if (nloc == 0u) { xcd_barrier_complete(bar, b.x, nloc, nx); b.st[0] = nloc; b.st[1] = nx; }
        const unsigned old = xb_add(&bar[XB_XSUB(b.x)], 1u);
        const unsigned gen = old / nloc;
        if (old + 1u == (gen + 1u) * nloc) {
            __builtin_amdgcn_fence(__ATOMIC_RELEASE, "agent");
            asm volatile("s_waitcnt vmcnt(0)" ::: "memory");
            const unsigned og = xb_add(&bar[XB_TOP], 1u);
            const unsigned tg = og / nx;
            if (og + 1u == (tg + 1u) * nx) xb_add(&bar[XB_TOPGEN], 1u);
            else XB_SPIN(xb_ld(&bar[XB_TOPGEN]) == tg, bar);
            __builtin_amdgcn_fence(__ATOMIC_ACQUIRE, "agent");
            xb_add(&bar[XB_XGEN(b.x)], 1u);
            asm volatile("s_waitcnt vmcnt(0)" ::: "memory");
        } else {
            XB_SPIN(xb_ld(&bar[XB_XGEN(b.x)]) == gen, bar);
            __builtin_amdgcn_fence(__ATOMIC_ACQUIRE, "agent");
            asm volatile("s_waitcnt vmcnt(0)" ::: "memory");
        }
    }
    __syncthreads();
}

struct Args { const float* in[18]; float* out; unsigned char* ws; int ph_lo, ph_hi, chk, pad; };
constexpr size_t WS_FLAG = 25 * MiB + 896 * 1024;
constexpr size_t WS_BAR = 25 * MiB + 928 * 1024;
constexpr int LDS_BARST = LDS_BYTES - 64;

DI void p0_transpose_item(const float* W, int K, int N, bf16_t* WT, LAS float* scr, int item, int lane, int mode) {
    const int nblk = N / 32, kb = item / nblk, nb = item % nblk, k0 = 64 * kb, n0 = 32 * nb;
    int r0 = n0;
    if (mode == 1) r0 = n0 < 1536 ? n0 : (n0 == 1536 ? C_RF : n0 - 32);
    else if (mode == 2) r0 = n0 < DFF ? (n0 / 128) * 256 + (n0 % 128) : ((n0 - DFF) / 128) * 256 + 128 + ((n0 - DFF) % 128);
#pragma unroll 8
    for (int i = 0; i < 32; ++i) { const int kk = 2 * i + (lane >> 5); scr[kk * 33 + (lane & 31)] = W[(size_t)(k0 + kk) * N + n0 + (lane & 31)]; }
    asm volatile("s_waitcnt lgkmcnt(0)" ::: "memory");
    const int c = lane & 7;
#pragma unroll
    for (int j = 0; j < 4; ++j) { const int n = (lane >> 3) + 8 * j; const LAS float* s = scr + (8 * c) * 33 + n;
        u32x4 o; o.x = pk2(s[0 * 33], s[1 * 33]); o.y = pk2(s[2 * 33], s[3 * 33]); o.z = pk2(s[4 * 33], s[5 * 33]); o.w = pk2(s[6 * 33], s[7 * 33]);
        *(u32x4*)(WT + (size_t)(r0 + n) * K + k0 + 8 * c) = o; }
    asm volatile("s_waitcnt lgkmcnt(0)" ::: "memory");
}
DI void rms_row_to_bf16(const float* xrow, const float* w, bf16_t* orow, int lane) {
    const f32x4* xr = (const f32x4*)xrow + lane; const f32x4* wr = (const f32x4*)w + lane;
    f32x4 v[4]; float s = 0.f;
#pragma unroll
    for (int j = 0; j < 4; ++j) { v[j] = xr[64 * j]; s += (v[j].x * v[j].x + v[j].y * v[j].y) + (v[j].z * v[j].z + v[j].w * v[j].w); }
    const float rstd = 1.0f / sqrtf(wave_sum(s) * (1.f / 1024.f) + RMS_EPS);
    u32x2* o8 = (u32x2*)orow + lane;
#pragma unroll
    for (int j = 0; j < 4; ++j) { const f32x4 g = wr[64 * j]; u32x2 o; o.x = pk2(v[j].x * rstd * g.x, v[j].y * rstd * g.y); o.y = pk2(v[j].z * rstd * g.z, v[j].w * rstd * g.w); o8[64 * j] = o; }
}
DI void rms_row2_to_bf16(const float* xa, const float* xb, const float* w, bf16_t* oa, bf16_t* ob, int lane) {
    const f32x4* pa = (const f32x4*)xa + lane; const f32x4* pb = (const f32x4*)xb + lane; const f32x4* wr = (const f32x4*)w + lane;
    f32x4 a[4], b[4]; float sa = 0.f, sb = 0.f;
#pragma unroll
    for (int j = 0; j < 4; ++j) { a[j] = pa[64 * j]; b[j] = pb[64 * j]; }
#pragma unroll
    for (int j = 0; j < 4; ++j) { sa += (a[j].x * a[j].x + a[j].y * a[j].y) + (a[j].z * a[j].z + a[j].w * a[j].w); sb += (b[j].x * b[j].x + b[j].y * b[j].y) + (b[j].z * b[j].z + b[j].w * b[j].w); }
    const float ra = 1.0f / sqrtf(wave_sum(sa) * (1.f / 1024.f) + RMS_EPS), rb = 1.0f / sqrtf(wave_sum(sb) * (1.f / 1024.f) + RMS_EPS);
    u32x2* qa = (u32x2*)oa + lane; u32x2* qb = (u32x2*)ob + lane;
#pragma unroll
    for (int j = 0; j < 4; ++j) { const f32x4 g = wr[64 * j];
        u32x2 o; o.x = pk2(a[j].x * ra * g.x, a[j].y * ra * g.y); o.y = pk2(a[j].z * ra * g.z, a[j].w * ra * g.w); qa[64 * j] = o;
        u32x2 p; p.x = pk2(b[j].x * rb * g.x, b[j].y * rb * g.y); p.y = pk2(b[j].z * rb * g.z, b[j].w * rb * g.w); qb[64 * j] = p; }
}
DI void rms_row_inplace(float* xrow, const float* w, int lane) {
    f32x4* xr = (f32x4*)xrow + lane; const f32x4* wr = (const f32x4*)w + lane;
    f32x4 v[4]; float s = 0.f;
#pragma unroll
    for (int j = 0; j < 4; ++j) { v[j] = xr[64 * j]; s += (v[j].x * v[j].x + v[j].y * v[j].y) + (v[j].z * v[j].z + v[j].w * v[j].w); }
    const float rstd = 1.0f / sqrtf(wave_sum(s) * (1.f / 1024.f) + RMS_EPS);
#pragma unroll
    for (int j = 0; j < 4; ++j) { const f32x4 g = wr[64 * j]; f32x4 o = v[j] * rstd * g;
#pragma unroll
        for (int e = 0; e < 4; ++e) if (!(fabsf(o[e]) < 1e30f)) o[e] = 12345.0f;
        xr[64 * j] = o; }
}

DI void rms_row_final_regs(const u32x4 a, const u32x4 b, float q, const float* w, float* orow, int lane) {
    const float rstd = 1.0f / sqrtf(q * (1.f / 1024.f) + RMS_EPS);
    const f32x4 g0 = ((const f32x4*)w)[2 * lane], g1 = ((const f32x4*)w)[2 * lane + 1], g2 = ((const f32x4*)w)[128 + 2 * lane], g3 = ((const f32x4*)w)[128 + 2 * lane + 1];
    f32x4* o = (f32x4*)orow;
    o[2 * lane] = (f32x4){bflo(a.x), bfhi(a.x), bflo(a.y), bfhi(a.y)} * rstd * g0; o[2 * lane + 1] = (f32x4){bflo(a.z), bfhi(a.z), bflo(a.w), bfhi(a.w)} * rstd * g1;
    o[128 + 2 * lane] = (f32x4){bflo(b.x), bfhi(b.x), bflo(b.y), bfhi(b.y)} * rstd * g2; o[128 + 2 * lane + 1] = (f32x4){bflo(b.z), bfhi(b.z), bflo(b.w), bfhi(b.w)} * rstd * g3;
}
DI void rms_row_final(const bf16_t* xrow, float q, const float* w, float* orow, int lane) {
    const float rstd = 1.0f / sqrtf(q * (1.f / 1024.f) + RMS_EPS);
    const u32x4 a = ((const u32x4*)xrow)[lane], b = ((const u32x4*)xrow)[64 + lane];
    const f32x4 g0 = ((const f32x4*)w)[2 * lane], g1 = ((const f32x4*)w)[2 * lane + 1], g2 = ((const f32x4*)w)[128 + 2 * lane], g3 = ((const f32x4*)w)[128 + 2 * lane + 1];
    f32x4* o = (f32x4*)orow;
    o[2 * lane] = (f32x4){bflo(a.x), bfhi(a.x), bflo(a.y), bfhi(a.y)} * rstd * g0; o[2 * lane + 1] = (f32x4){bflo(a.z), bfhi(a.z), bflo(a.w), bfhi(a.w)} * rstd * g1;
    o[128 + 2 * lane] = (f32x4){bflo(b.x), bfhi(b.x), bflo(b.y), bfhi(b.y)} * rstd * g2; o[128 + 2 * lane + 1] = (f32x4){bflo(b.z), bfhi(b.z), bflo(b.w), bfhi(b.w)} * rstd * g3;
}

constexpr int G_RF = 0, G_WG = 8192, G_BIAS = 16384, G_BF = 16896, G_BB = 33280, G_Q0 = 50688, G_VT = 87552, G_AF = 105984, G_AB = 115200, G_END = 124416;
constexpr int GP = 72;
struct GlaIn { const bf16_t* proj; const float *wgf, *bgf, *wgb, *bgb; };
DI float logsig16(float x) { return (fminf(x, 0.f) - __logf(1.0f + __expf(-fabsf(x)))) * 0.0625f; }
DI void lds_barrier() { asm volatile("s_waitcnt lgkmcnt(0)" ::: "memory"); __builtin_amdgcn_s_barrier(); asm volatile("" ::: "memory"); }
struct GlaPre { bf16x8 a; float w[8]; float bi; };
struct G1Loads { GlaPre pre; u32x4 kv, vv0, vv1; };
struct G3Loads { GlaPre pre; u32x4 qv, kv, vv0, vv1, g0, g1; bf16x8 s0[4], s1[4]; };
DI void gla_issue_pre(GlaPre& P, const GlaIn& gi, int tok0, int h, int tid) {
    const int lane = tid & 63, w = tid >> 6, dir = w >> 2, mt = (w >> 1) & 1, nd = w & 1, r32 = lane & 31, hi = lane >> 5;
    P.a = *(const bf16x8*)(gi.proj + (size_t)(tok0 + mt * 32 + r32) * NPROJ + C_RF + dir * 16 + hi * 8);
    const float* wsrc = (dir ? gi.wgb : gi.wgf) + (8 * hi) * 256 + h * 64 + nd * 32 + r32;
#pragma unroll
    for (int j = 0; j < 8; ++j) P.w[j] = wsrc[j * 256];
    P.bi = (dir ? gi.bgb : gi.bgf)[h * 64 + nd * 32 + r32];
}
DI void g1_issue(G1Loads& L, const GlaIn& gi, int item, int tid) {
    const int c = item & 255, h = (item >> 8) & 3, b = item >> 10, tok0 = b * SEQL + c * 64;
    gla_issue_pre(L.pre, gi, tok0, h, tid);
    const bf16_t* prow = gi.proj + (size_t)(tok0 + (tid >> 3)) * NPROJ;
    L.kv = *(const u32x4*)(prow + C_GK + h * 64 + (tid & 7) * 8);
    L.vv0 = *(const u32x4*)(prow + C_GV + h * 128 + (tid & 7) * 16); L.vv1 = *(const u32x4*)(prow + C_GV + h * 128 + (tid & 7) * 16 + 8);
}
DI void g3_issue(G3Loads& L, const GlaIn& gi, const bf16_t* sbuf, int item, int tid) {
    const int c = item & 255, h = (item >> 8) & 3, b = item >> 10, tok0 = b * SEQL + c * 64;
    gla_issue_pre(L.pre, gi, tok0, h, tid);
    const bf16_t* prow = gi.proj + (size_t)(tok0 + (tid >> 3)) * NPROJ;
    L.qv = *(const u32x4*)(prow + C_GQ + h * 64 + (tid & 7) * 8); L.kv = *(const u32x4*)(prow + C_GK + h * 64 + (tid & 7) * 8);
    L.vv0 = *(const u32x4*)(prow + C_GV + h * 128 + (tid & 7) * 16); L.vv1 = *(const u32x4*)(prow + C_GV + h * 128 + (tid & 7) * 16 + 8);
    L.g0 = *(const u32x4*)(prow + C_GG + h * 128 + (tid & 7) * 16); L.g1 = *(const u32x4*)(prow + C_GG + h * 128 + (tid & 7) * 16 + 8);
    const int lane = tid & 63, w = tid >> 6, nv = w & 3, r32 = lane & 31, hi = lane >> 5;
    const bf16_t* s0 = sbuf + (size_t)item * 8192 + (nv * 32 + r32) * 64 + hi * 8; const bf16_t* s1 = s0 + (size_t)NITEM * 8192;
#pragma unroll
    for (int ks = 0; ks < 4; ++ks) { L.s0[ks] = *(const bf16x8*)(s0 + ks * 16); L.s1[ks] = *(const bf16x8*)(s1 + ks * 16); }
}
DI void gla_preamble(LAS unsigned char* lds, const GlaPre& P, int tid) {
    LAS float* RF = (LAS float*)(lds + G_RF);
    LAS float* BF = (LAS float*)(lds + G_BF); LAS float* BB = (LAS float*)(lds + G_BB);
    {
        const int lane = tid & 63, w = tid >> 6, dir = w >> 2, mt = (w >> 1) & 1, nd = w & 1, r32 = lane & 31, hi = lane >> 5;
        const u32x4 bw = {pk2(P.w[0], P.w[1]), pk2(P.w[2], P.w[3]), pk2(P.w[4], P.w[5]), pk2(P.w[6], P.w[7])};
        f32x16 acc = {}; acc = __builtin_amdgcn_mfma_f32_32x32x16_bf16(P.a, __builtin_bit_cast(bf16x8, bw), acc, 0, 0, 0);
        LAS float* dst = (dir ? BB : BF) + (mt * 32) * 64 + nd * 32 + r32;
#pragma unroll
        for (int r = 0; r < 16; ++r) dst[crow16(r, hi) * 64] = logsig16(acc[r] + P.bi); }
    lds_barrier();
    {
        const int d = tid & 63, seg = (tid >> 6) & 3, dir = tid >> 8; LAS float* SEGT = RF;
        LAS float* Bd = (dir ? BB : BF) + d; float v[16];
#pragma unroll
        for (int i = 0; i < 16; ++i) v[i] = Bd[(dir ? (seg * 16 + 15 - i) : (seg * 16 + i)) * 64];
#pragma unroll
        for (int i = 1; i < 16; ++i) v[i] += v[i - 1];
        SEGT[(dir * 4 + seg) * 64 + d] = v[15];
        lds_barrier();
        float off = 0.f;
#pragma unroll
        for (int s2 = 0; s2 < 4; ++s2) { const float tt = SEGT[(dir * 4 + s2) * 64 + d]; if (dir ? (s2 > seg) : (s2 < seg)) off += tt; }
#pragma unroll
        for (int i = 0; i < 16; ++i) Bd[(dir ? (seg * 16 + 15 - i) : (seg * 16 + i)) * 64] = v[i] + off;
    }
    lds_barrier();
}
DI void gla_store_vt(LAS unsigned char* lds, const u32x4 v0, const u32x4 v1, int tid) {
    LAS bf16_t* VT = (LAS bf16_t*)(lds + G_VT); const int t = tid >> 3, j = tid & 7;
    LAS bf16_t* d = VT + (j * 16) * GP + t;
    d[0 * GP] = (bf16_t)(v0.x & 0xffffu); d[1 * GP] = (bf16_t)(v0.x >> 16); d[2 * GP] = (bf16_t)(v0.y & 0xffffu); d[3 * GP] = (bf16_t)(v0.y >> 16);
    d[4 * GP] = (bf16_t)(v0.z & 0xffffu); d[5 * GP] = (bf16_t)(v0.z >> 16); d[6 * GP] = (bf16_t)(v0.w & 0xffffu); d[7 * GP] = (bf16_t)(v0.w >> 16);
    d[8 * GP] = (bf16_t)(v1.x & 0xffffu); d[9 * GP] = (bf16_t)(v1.x >> 16); d[10 * GP] = (bf16_t)(v1.y & 0xffffu); d[11 * GP] = (bf16_t)(v1.y >> 16);
    d[12 * GP] = (bf16_t)(v1.z & 0xffffu); d[13 * GP] = (bf16_t)(v1.z >> 16); d[14 * GP] = (bf16_t)(v1.w & 0xffffu); d[15 * GP] = (bf16_t)(v1.w >> 16);
}
DI void gla_g1_item(LAS unsigned char* lds, const G1Loads& L, bf16_t* sbuf, float* dec, int item, int tid, unsigned* fl) {
    const int lane = tid & 63, w = tid >> 6, r32 = lane & 31, hi = lane >> 5;
    const u32x4 kv = L.kv, vv0 = L.vv0, vv1 = L.vv1;
    gla_preamble(lds, L.pre, tid);
    LAS float* BF = (LAS float*)(lds + G_BF); LAS float* BB = (LAS float*)(lds + G_BB);
    LAS bf16_t* KEF = (LAS bf16_t*)(lds + G_Q0); LAS bf16_t* KEB = KEF + 64 * GP; LAS bf16_t* VT = (LAS bf16_t*)(lds + G_VT);
#if MK_DIAG
    { const LAS float* RFd = (const LAS float*)(lds + G_RF); bool b12 = false, b13 = false; for (int i = tid; i < 2048; i += 512) b12 |= !(fabsf(RFd[i]) < 1e30f);
      for (int i = tid; i < 4096; i += 512) b13 |= !(fabsf(BF[i]) < 1e30f) | !(fabsf(BB[i]) < 1e30f) | (BF[i] > 0.f) | (BB[i] > 0.f);
      if (b12) atomicOr(fl + 12, 1u); if (b13) atomicOr(fl + 13, 1u); }
#endif
    { const int t = tid >> 3, d0 = (tid & 7) * 8;
        const float kf[8] = {bflo(kv.x), bfhi(kv.x), bflo(kv.y), bfhi(kv.y), bflo(kv.z), bfhi(kv.z), bflo(kv.w), bfhi(kv.w)};
#pragma unroll
        for (int i = 0; i < 8; ++i) { const int d = d0 + i; const float ef = __expf(BF[63 * 64 + d] - BF[t * 64 + d]), eb = __expf(BB[d] - BB[t * 64 + d]);
            KEF[d * GP + t] = f2bf(kf[i] * ef); KEB[d * GP + t] = f2bf(kf[i] * eb); } }
    gla_store_vt(lds, vv0, vv1, tid);
    if (tid < 64) dec[(size_t)item * 64 + tid] = __expf(BF[63 * 64 + tid]);
    else if (tid < 128) dec[(size_t)(NITEM + item) * 64 + (tid - 64)] = __expf(BB[tid - 64]);
    lds_barrier();
#if MK_DIAG
    { bool b14 = false; for (int i = tid; i < 64 * GP; i += 512) { if ((i % GP) < 64) b14 |= ((KEF[i] & 0x7F80) == 0x7F80) | ((KEB[i] & 0x7F80) == 0x7F80); }
      for (int i = tid; i < 128 * GP; i += 512) { if ((i % GP) < 64) b14 |= ((VT[i] & 0x7F80) == 0x7F80); } if (b14) atomicOr(fl + 14, 1u); }
#endif
    { const int mv = w >> 1, nk = w & 1;
#pragma unroll
        for (int dir = 0; dir < 2; ++dir) { const LAS bf16_t* KE = dir ? KEB : KEF; f32x16 acc = {};
#pragma unroll
            for (int ks = 0; ks < 4; ++ks) { const bf16x8 A = *(const LAS bf16x8*)(VT + (mv * 32 + r32) * GP + ks * 16 + hi * 8), B = *(const LAS bf16x8*)(KE + (nk * 32 + r32) * GP + ks * 16 + hi * 8);
                acc = __builtin_amdgcn_mfma_f32_32x32x16_bf16(A, B, acc, 0, 0, 0); }
            bf16_t* dst = sbuf + (size_t)(dir * NITEM + item) * 8192;
#pragma unroll
            for (int r = 0; r < 16; ++r) { dst[(mv * 32 + crow16(r, hi)) * 64 + nk * 32 + r32] = f2bf(acc[r]);
#if MK_DIAG
                if (!(fabsf(acc[r]) < 1e30f)) atomicOr(fl + 15, 1u);
#endif
            } } }
    lds_barrier();
}
DI void gla_g3_item(LAS unsigned char* lds, const G3Loads& L, const float* onorm, bf16_t* omix, int item, int tid) {
    const int c = item & 255, h = (item >> 8) & 3, b = item >> 10, tok0 = b * SEQL + c * 64;
    const int lane = tid & 63, w = tid >> 6, r32 = lane & 31, hi = lane >> 5;
    const u32x4 qv = L.qv, kv = L.kv, vv0 = L.vv0, vv1 = L.vv1;
    gla_preamble(lds, L.pre, tid);
    LAS float* BF = (LAS float*)(lds + G_BF); LAS float* BB = (LAS float*)(lds + G_BB);
    LAS bf16_t* QF = (LAS bf16_t*)(lds + G_Q0); LAS bf16_t* KF = QF + 64 * GP; LAS bf16_t* QB = KF + 64 * GP; LAS bf16_t* KB = QB + 64 * GP;
    LAS bf16_t* VT = (LAS bf16_t*)(lds + G_VT); LAS bf16_t* AF = (LAS bf16_t*)(lds + G_AF); LAS bf16_t* AB = (LAS bf16_t*)(lds + G_AB);
    { const int t = tid >> 3, d0 = (tid & 7) * 8;
        const float qf[8] = {bflo(qv.x), bfhi(qv.x), bflo(qv.y), bfhi(qv.y), bflo(qv.z), bfhi(qv.z), bflo(qv.w), bfhi(qv.w)};
        const float kf[8] = {bflo(kv.x), bfhi(kv.x), bflo(kv.y), bfhi(kv.y), bflo(kv.z), bfhi(kv.z), bflo(kv.w), bfhi(kv.w)};
        float oqf[8], okf[8], oqb[8], okb[8];
#pragma unroll
        for (int i = 0; i < 8; ++i) { const float bf = BF[t * 64 + d0 + i], bb = BB[t * 64 + d0 + i];
            oqf[i] = qf[i] * 0.125f * __expf(bf); okf[i] = kf[i] * __expf(-bf); oqb[i] = qf[i] * 0.125f * __expf(bb); okb[i] = kf[i] * __expf(-bb); }
        *(LAS u32x4*)(QF + t * GP + d0) = (u32x4){pk2(oqf[0], oqf[1]), pk2(oqf[2], oqf[3]), pk2(oqf[4], oqf[5]), pk2(oqf[6], oqf[7])};
        *(LAS u32x4*)(KF + t * GP + d0) = (u32x4){pk2(okf[0], okf[1]), pk2(okf[2], okf[3]), pk2(okf[4], okf[5]), pk2(okf[6], okf[7])};
        *(LAS u32x4*)(QB + t * GP + d0) = (u32x4){pk2(oqb[0], oqb[1]), pk2(oqb[2], oqb[3]), pk2(oqb[4], oqb[5]), pk2(oqb[6], oqb[7])};
        *(LAS u32x4*)(KB + t * GP + d0) = (u32x4){pk2(okb[0], okb[1]), pk2(okb[2], okb[3]), pk2(okb[4], okb[5]), pk2(okb[6], okb[7])}; }
    gla_store_vt(lds, vv0, vv1, tid);
    lds_barrier();
    { const int dir = w >> 2, w4 = w & 3, mt = w4 >> 1, ns = w4 & 1; const LAS bf16_t* Qd = dir ? QB : QF; const LAS bf16_t* Kd = dir ? KB : KF; LAS bf16_t* Ad = dir ? AB : AF;
        f32x16 acc = {};
#pragma unroll
        for (int ks = 0; ks < 4; ++ks) { const bf16x8 A = *(const LAS bf16x8*)(Qd + (mt * 32 + r32) * GP + ks * 16 + hi * 8), B = *(const LAS bf16x8*)(Kd + (ns * 32 + r32) * GP + ks * 16 + hi * 8);
            acc = __builtin_amdgcn_mfma_f32_32x32x16_bf16(A, B, acc, 0, 0, 0); }
#pragma unroll
        for (int r = 0; r < 16; ++r) { const int tt = mt * 32 + crow16(r, hi), ss = ns * 32 + r32; const bool keep = dir ? (ss >= tt) : (ss <= tt);
            Ad[tt * GP + ss] = f2bf(keep ? acc[r] : 0.f); } }
    lds_barrier();
    { const int mt = w >> 2, nv = w & 3; f32x16 acc = {}, acc2 = {};
#pragma unroll
        for (int ks = 0; ks < 4; ++ks) acc = __builtin_amdgcn_mfma_f32_32x32x16_bf16(*(const LAS bf16x8*)(AF + (mt * 32 + r32) * GP + ks * 16 + hi * 8), *(const LAS bf16x8*)(VT + (nv * 32 + r32) * GP + ks * 16 + hi * 8), acc, 0, 0, 0);
#pragma unroll
        for (int ks = 0; ks < 4; ++ks) acc2 = __builtin_amdgcn_mfma_f32_32x32x16_bf16(*(const LAS bf16x8*)(AB + (mt * 32 + r32) * GP + ks * 16 + hi * 8), *(const LAS bf16x8*)(VT + (nv * 32 + r32) * GP + ks * 16 + hi * 8), acc2, 0, 0, 0);
#pragma unroll
        for (int ks = 0; ks < 4; ++ks) acc = __builtin_amdgcn_mfma_f32_32x32x16_bf16(*(const LAS bf16x8*)(QF + (mt * 32 + r32) * GP + ks * 16 + hi * 8), L.s0[ks], acc, 0, 0, 0);
#pragma unroll
        for (int ks = 0; ks < 4; ++ks) acc2 = __builtin_amdgcn_mfma_f32_32x32x16_bf16(*(const LAS bf16x8*)(QB + (mt * 32 + r32) * GP + ks * 16 + hi * 8), L.s1[ks], acc2, 0, 0, 0);
        acc += acc2;
        LAS float* OS = (LAS float*)(lds + G_BF);
#pragma unroll
        for (int r = 0; r < 16; ++r) OS[(mt * 32 + crow16(r, hi)) * 132 + nv * 32 + r32] = acc[r]; }
    lds_barrier();
    { const int t = tid >> 3, dv0 = (tid & 7) * 16; const LAS float* OS = (const LAS float*)(lds + G_BF) + t * 132 + dv0;
        f32x4 o[4]; float ss = 0.f;
#pragma unroll
        for (int i = 0; i < 4; ++i) { o[i] = *(const LAS f32x4*)(OS + 4 * i); ss += (o[i].x * o[i].x + o[i].y * o[i].y) + (o[i].z * o[i].z + o[i].w * o[i].w); }
        ss += __shfl_xor(ss, 1); ss += __shfl_xor(ss, 2); ss += __shfl_xor(ss, 4);
        const float rstd = 1.0f / sqrtf(ss * (1.f / 128.f) + RMS_EPS);
        const u32x4 g0 = L.g0, g1 = L.g1;
        const float gg[16] = {bflo(g0.x), bfhi(g0.x), bflo(g0.y), bfhi(g0.y), bflo(g0.z), bfhi(g0.z), bflo(g0.w), bfhi(g0.w), bflo(g1.x), bfhi(g1.x), bflo(g1.y), bfhi(g1.y), bflo(g1.z), bfhi(g1.z), bflo(g1.w), bfhi(g1.w)};
        float res[16];
#pragma unroll
        for (int i = 0; i < 4; ++i) { const f32x4 on = *(const f32x4*)(onorm + dv0 + 4 * i);
#pragma unroll
            for (int e = 0; e < 4; ++e) { const float g = gg[4 * i + e]; res[4 * i + e] = o[i][e] * rstd * on[e] * (g * __builtin_amdgcn_rcpf(1.0f + __expf(-g))); } }
        bf16_t* op = omix + (size_t)(tok0 + t) * 1024 + h * 128 + dv0;
        *(u32x4*)op = (u32x4){pk2(res[0], res[1]), pk2(res[2], res[3]), pk2(res[4], res[5]), pk2(res[6], res[7])};
        *(u32x4*)(op + 8) = (u32x4){pk2(res[8], res[9]), pk2(res[10], res[11]), pk2(res[12], res[13]), pk2(res[14], res[15])}; }
    lds_barrier();
}

DI void qk_prep_item(bf16_t* proj, const float* qn, const float* kn, const float* tab, int tok, int j) {
    bf16_t* p = proj + (size_t)tok * NPROJ + (j < 8 ? C_AQ + j * 64 : C_AK + (j - 8) * 64);
    const float* wn = j < 8 ? qn : kn; const float sc = j < 8 ? attn_body::C2 : 1.0f;
    const int t = tok % SEQL, prow = t >> 6, pcol = 256 + (t & 63);
    float x[64]; float ss = 0.f;
#pragma unroll
    for (int i = 0; i < 8; ++i) { const u32x4 v = *(const u32x4*)(p + 8 * i);
        x[8 * i + 0] = bflo(v.x); x[8 * i + 1] = bfhi(v.x); x[8 * i + 2] = bflo(v.y); x[8 * i + 3] = bfhi(v.y); x[8 * i + 4] = bflo(v.z); x[8 * i + 5] = bfhi(v.z); x[8 * i + 6] = bflo(v.w); x[8 * i + 7] = bfhi(v.w); }
#pragma unroll
    for (int i = 0; i < 64; ++i) ss += x[i] * x[i];
    const float rstd = sc / sqrtf(ss * (1.f / 64.f) + RMS_EPS);
#pragma unroll
    for (int i = 0; i < 16; ++i) { const f32x4 w4 = *(const f32x4*)(wn + 4 * i);
        x[4 * i] *= rstd * w4.x; x[4 * i + 1] *= rstd * w4.y; x[4 * i + 2] *= rstd * w4.z; x[4 * i + 3] *= rstd * w4.w; }
    float y[64];
#pragma unroll
    for (int i = 0; i < 16; ++i) {
        const float cr = tab[(prow * 16 + i) * 2], sr = tab[(prow * 16 + i) * 2 + 1], cc = tab[(pcol * 16 + i) * 2], sn = tab[(pcol * 16 + i) * 2 + 1];
        y[i] = x[i] * cr - x[i + 16] * sr; y[i + 16] = x[i] * sr + x[i + 16] * cr;
        y[32 + i] = x[32 + i] * cc - x[48 + i] * sn; y[48 + i] = x[32 + i] * sn + x[48 + i] * cc; }
#pragma unroll
    for (int i = 0; i < 8; ++i) *(u32x4*)(p + 8 * i) = (u32x4){pk2(y[8 * i], y[8 * i + 1]), pk2(y[8 * i + 2], y[8 * i + 3]), pk2(y[8 * i + 4], y[8 * i + 5]), pk2(y[8 * i + 6], y[8 * i + 7])};
}


#if MK_DIAG
DI bool bad16(unsigned w) { return (w & 0x7F80u) == 0x7F80u || (w & 0x7F800000u) == 0x7F800000u; }
DI void chk16_2d(const bf16_t* p, int rows, int pitch, int col0, int ncols, unsigned* flag, int gt, int NGT) {
    bool bad = false; const int per = ncols / 8; const size_t n = (size_t)rows * per;
    for (size_t i = gt; i < n; i += NGT) { const size_t r = i / per; const int c = (int)(i % per); const u32x4 v = *(const u32x4*)(p + r * pitch + col0 + c * 8); bad |= bad16(v.x) | bad16(v.y) | bad16(v.z) | bad16(v.w); }
    if (bad) atomicOr(flag, 1u);
}
DI void chk32(const float* p, size_t n, unsigned* flag, int gt, int NGT) {
    bool bad = false;
    for (size_t i = gt; i < n / 4; i += NGT) { const u32x4 v = ((const u32x4*)p)[i]; bad |= ((v.x & 0x7F800000u) == 0x7F800000u) | ((v.y & 0x7F800000u) == 0x7F800000u) | ((v.z & 0x7F800000u) == 0x7F800000u) | ((v.w & 0x7F800000u) == 0x7F800000u); }
    if (bad) atomicOr(flag, 1u);
}
#endif
__global__ void __launch_bounds__(NTHR, 2) hymba_fwd(Args args) {
    __shared__ __attribute__((aligned(16))) unsigned char lds_raw[LDS_BYTES];
    LAS unsigned char* lds = (LAS unsigned char*)lds_raw;
    const int tid = threadIdx.x, lane = tid & 63, wave = __builtin_amdgcn_readfirstlane(tid >> 6);
    const int G = gridDim.x, bx = blockIdx.x;
    const int vcu = (G % 8 == 0) ? (bx % 8) * (G / 8) + bx / 8 : bx;
    unsigned char* ws = args.ws;
    const float* x_prompt = args.in[0]; const float* x_sample = args.in[1]; const float* ln_mix = args.in[2]; const float* w_in = args.in[3];
    const float* w_gk_f = args.in[4]; const float* b_gk_f = args.in[5]; const float* w_gk_b = args.in[6]; const float* b_gk_b = args.in[7];
    const float* gla_on = args.in[8]; const float* q_norm = args.in[9]; const float* k_norm = args.in[10]; const float* w_out = args.in[11];
    const float* ln_ffn = args.in[12]; const float* w_up = args.in[13]; const float* conv_w = args.in[14]; const float* conv_b = args.in[15];
    const float* w_down = args.in[16]; const float* ln_final = args.in[17];
    float* out = args.out;
    bf16_t* WinT = (bf16_t*)(ws + WS_WIN); bf16_t* WoutT = (bf16_t*)(ws + WS_WOUT); bf16_t* WupT = (bf16_t*)(ws + WS_WUP); bf16_t* WdnT = (bf16_t*)(ws + WS_WDN);
    float* rope = (float*)(ws + WS_ROPE); float* dec = (float*)(ws + WS_DEC);
    bf16_t* Hbuf = (bf16_t*)(ws + WS_H); bf16_t* Hrow = Hbuf + 1024;
    bf16_t* H2 = (bf16_t*)(ws + WS_H2); float* ssq = (float*)(ws + WS_SSQ); float* ssq2 = (float*)(ws + WS_SSQ2);
    bf16_t* proj = (bf16_t*)(ws + WS_A); bf16_t* act = (bf16_t*)(ws + WS_A); bf16_t* sbuf = (bf16_t*)(ws + WS_S);
    const int lo = args.ph_lo, hi = args.ph_hi;
    XcdBarrier xbar; xbar.bar = (unsigned*)(ws + WS_BAR); xbar.x = 0; xbar.st = (volatile LAS unsigned*)(lds + LDS_BARST);
    if (!MK_PER_PHASE) { if (tid < 2) ((volatile LAS unsigned*)(lds + LDS_BARST))[tid] = 0u; __syncthreads(); xbar = xcd_barrier_post((unsigned*)(ws + WS_BAR), (volatile LAS unsigned*)(lds + LDS_BARST)); }
    const int gw = vcu * NWAVES + wave, NGW = G * NWAVES, gt = bx * NTHR + tid, NGT = G * NTHR;

#if MK_DIAG
    if (args.chk >= 0) { unsigned* fl = (unsigned*)(ws + WS_FLAG); const int k = args.chk;
        if (k == 0) { chk16_2d(WinT, 1, 0, 0, (int)((WS_WDN + (size_t)1024 * DFF * 2) / 2), fl + 0, gt, NGT); chk32(rope, 320 * 32, fl + 0, gt, NGT); chk16_2d(Hrow, TOK, 1024, 0, 1024, fl + 1, gt, NGT); }
        if (k == 1) chk16_2d(proj, TOK, NPROJ, 0, NPROJ, fl + 2, gt, NGT);
        if (k == 2) { chk16_2d(proj, TOK, NPROJ, 0, NPROJ, fl + 3, gt, NGT); chk16_2d(sbuf, 2 * NITEM, 8192, 0, 8192, fl + 4, gt, NGT); chk32(dec, (size_t)2 * NITEM * 64, fl + 16, gt, NGT); }
        if (k == 3) chk16_2d(sbuf, 2 * NITEM, 8192, 0, 8192, fl + 5, gt, NGT);
        if (k == 4) { chk16_2d(Hrow, TOK, 1024, 0, 512, fl + 6, gt, NGT); chk16_2d(Hrow, TOK, 1024, 512, 512, fl + 7, gt, NGT); }
        if (k == 5) chk32(out, (size_t)TOK * 1024, fl + 8, gt, NGT);
        if (k == 6) chk16_2d(Hbuf, TOK + 257, 1024, 0, 1024, fl + 9, gt, NGT);
        if (k == 7) chk16_2d(act, TOK, DFF, 0, DFF, fl + 10, gt, NGT);
        if (k == 8) chk32(out, (size_t)TOK * 1024, fl + 11, gt, NGT);
        if (k == 99) { const int order[16] = {0, 1, 2, 3, 12, 13, 14, 15, 16, 4, 5, 6, 8, 9, 10, 11}; int first = -1;
#pragma unroll
            for (int i = 15; i >= 0; --i) if (fl[order[i]]) first = i;
            float v = first < 0 ? 1.0f : (float)(first + 2); if (fl[7]) v *= 30.0f;
            for (size_t i = gt; i < (size_t)TOK * 1024; i += NGT) out[i] = v; }
        return; }
#endif
#define IN(k) (lo <= (k) && (k) < hi)
#define SEAM(k) do { if (IN(k) && IN((k) + 1)) { xcd_barrier(xbar); } } while (0)
    if (args.ph_hi > 1000) cg::this_grid().sync();

    for (int rep0 = 0; rep0 < REP_P0; ++rep0) if (IN(0)) {
        LAS float* scr = (LAS float*)(lds + wave * 16384);
        constexpr int I_IN = 16 * (INW / 32), I_OUT = 16 * 32, I_UP = 16 * (NUP / 32), I_DN = (DFF / 64) * 32, NIT = I_IN + I_OUT + I_UP + I_DN;
        for (int it = gw; it < NIT; it += NGW) {
            int r = it;
            if (r < I_IN) { p0_transpose_item(w_in, 1024, INW, WinT, scr, r, lane, 1); continue; } r -= I_IN;
            if (r < I_OUT) { p0_transpose_item(w_out, 1024, 1024, WoutT, scr, r, lane, 0); continue; } r -= I_OUT;
            if (r < I_UP) { p0_transpose_item(w_up, 1024, NUP, WupT, scr, r, lane, 2); continue; } r -= I_UP;
            p0_transpose_item(w_down, DFF, 1024, WdnT, scr, r, lane, 0);
        }
        for (int i = gt; i < (NPROJ - INW) * 1024 / 8; i += NGT) ((u32x4*)(WinT + (size_t)INW * 1024))[i] = (u32x4){0u, 0u, 0u, 0u};
        for (int i = gt; i < 320 * 16; i += NGT) { const int p = i >> 4, f = i & 15; const int pos = p < 256 ? p : p - 256;
            double inv = 1.0; for (int k = 0; k < f; ++k) inv *= 0.56234132519034908;
            double turns = (double)pos * inv * 0.15915494309189535; turns -= floor(turns); const float xt = (float)turns;
            rope[2 * i] = __builtin_amdgcn_cosf(xt); rope[2 * i + 1] = __builtin_amdgcn_sinf(xt); }
        for (int i = gt; i < TOK; i += NGT) { ssq[i] = 0.f; ssq2[i] = 0.f; }
        for (int i = gt; i < 257 * 128; i += NGT) { const int r = i >> 7, c = i & 127; const size_t row = r == 0 ? 0 : (size_t)TOK + r; ((u32x4*)(H2 + row * 1024))[c] = (u32x4){0u, 0u, 0u, 0u}; }
        for (int m = gw; m < TOK; m += 2 * NGW) {
            const int m2 = m + NGW;
            const float* xa = m < 2 * SEQL ? x_prompt + (size_t)m * 1024 : x_sample + (size_t)(m - 2 * SEQL) * 1024;
            const float* xb = m2 < 2 * SEQL ? x_prompt + (size_t)m2 * 1024 : x_sample + (size_t)(m2 - 2 * SEQL) * 1024;
            rms_row2_to_bf16(xa, xb, ln_mix, Hrow + (size_t)m * 1024, Hrow + (size_t)m2 * 1024, lane); }
    }
    SEAM(0);
    if (IN(1)) {
        pg8::Gemm g{Hbuf, WinT, TOK, NPROJ, 1024}; pg8::StaticOrder S; S.init(TOK, NPROJ, G, bx, 1);
        pg8::EpiBf16<0> E{proj, NPROJ, nullptr, 0, 0, 1.f};
        pg8::gemm_phase<pg8::EpiBf16<0>, pg8::StaticOrder, true, true>(lds, g, S, E);
    }
    SEAM(1);
    if (IN(2)) {
        for (int i = gt; i < TOK * 10; i += NGT) qk_prep_item(proj, q_norm, k_norm, rope, i / 10, i % 10);
        const GlaIn gi{proj, w_gk_f, b_gk_f, w_gk_b, b_gk_b};
        for (int rep = 0; rep < REP_G1; ++rep) { G1Loads cur; g1_issue(cur, gi, vcu < NITEM ? vcu : 0, tid);
            for (int it = vcu; it < NITEM; it += G) { G1Loads nxt; g1_issue(nxt, gi, it + G < NITEM ? it + G : it, tid);
                gla_g1_item(lds, cur, sbuf, dec, it, tid, (unsigned*)(ws + WS_FLAG)); cur = nxt; } }
    }
    SEAM(2);
    if (IN(3)) {
        if (gt < 24 * 4096) { const int chain = gt >> 12, e2 = gt & 4095, dir = chain / 12, bh = chain % 12;
            unsigned* sp = (unsigned*)(sbuf + (size_t)(dir * NITEM + bh * 256) * 8192) + e2;
            const float* dp = dec + (size_t)(dir * NITEM + bh * 256) * 64 + ((2 * e2) & 63);
            float S0 = 0.f, S1 = 0.f;
            typedef float f32x2 __attribute__((ext_vector_type(2)));
            for (int cb = 0; cb < 256; cb += 32) { unsigned v[32]; f32x2 dd[32];
#pragma unroll
                for (int i = 0; i < 32; ++i) { const int c = dir ? 255 - (cb + i) : cb + i; v[i] = sp[(size_t)c * 4096]; dd[i] = *(const f32x2*)(dp + c * 64); }
#pragma unroll
                for (int i = 0; i < 32; ++i) { const int c = dir ? 255 - (cb + i) : cb + i; sp[(size_t)c * 4096] = pk2(S0, S1); S0 = S0 * dd[i].x + bflo(v[i]); S1 = S1 * dd[i].y + bfhi(v[i]); } } }
    }
    SEAM(3);
    if (IN(4)) {
        const GlaIn gi{proj, w_gk_f, b_gk_f, w_gk_b, b_gk_b};
        for (int rep = 0; rep < REP_G3; ++rep) { G3Loads cur; g3_issue(cur, gi, sbuf, vcu < NITEM ? vcu : 0, tid);
            for (int it = vcu; it < NITEM; it += G) { G3Loads nxt; g3_issue(nxt, gi, sbuf, it + G < NITEM ? it + G : it, tid);
                gla_g3_item(lds, cur, gla_on, Hrow, it, tid); cur = nxt; } }
        float mq = 0.f, mk = 0.f;
        for (int i = 0; i < 64; ++i) { mq = fmaxf(mq, fabsf(q_norm[i])); mk = fmaxf(mk, fabsf(k_norm[i])); }
        const float mfix = attn_body::C2 * 64.0f * mq * mk * 1.02f + 0.25f;
        for (int rep = 0; rep < REP_ATT; ++rep) for (int id = vcu; id < NSEQ * 8 * 64; id += G) {
            const int pair = id >> 8, v = id & 255, b = pair >> 1, kvh = pair & 1, h = kvh * 4 + (v >> 6), qb = v & 63;
            const attn_body::bf16* base = (const attn_body::bf16*)proj + (size_t)b * SEQL * NPROJ;
            attn_body::attn_unit<8>(qb, base + C_AQ + h * 64, base + C_AK + kvh * 64, base + C_AV + kvh * 64, (attn_body::bf16*)Hrow + (size_t)b * SEQL * 1024 + 512 + h * 64, (char*)lds_raw, mfix);
        }
    }
    SEAM(4);
    if (IN(5)) {
        pg8::Gemm g{Hbuf, WoutT, TOK, 1024, 1024}; pg8::StaticOrder S; S.init(TOK, 1024, G, bx, 1);
        pg8::EpiResidNorm E{x_prompt, x_sample, 2 * SEQL, out, H2 + 1024, ln_ffn, ssq};
        pg8::gemm_phase<pg8::EpiResidNorm, pg8::StaticOrder, true, true>(lds, g, S, E);
    }
    SEAM(5);
    if (IN(7)) {
#if P7_PIPE
        pg8::Gemm g{H2, WupT, TOK, NUP, 1024}; const pg8::UpOrder S{G, vcu};
        const pg8::EpiConvGate2 E{act, conv_w, conv_b, (LAS float*)(lds + 131072), ssq};
        for (int rep = 0; rep < REP_P7; ++rep) pg8::gemm_phase<pg8::EpiConvGate2, pg8::UpOrder, true, true>(lds, g, S, E);
#else
        constexpr int MT = 65, NUNIT = NSEQ * MT * 22;
        pg8::Gemm g{H2, WupT, TOK, NUP, 1024};
        for (int rep = 0; rep < REP_P7; ++rep) for (int id = vcu; id < NUNIT; id += G) {
            const int mtile = id / 22, pn = id % 22, b = mtile / MT, i = mtile % MT;
            pg8::OneUnit S; S.u0.pm = mtile; S.u0.pn = pn; S.u0.arow = b * SEQL + 254 * i;
            pg8::EpiConvGate E{act, conv_w, conv_b, 254 * i - 1, b * SEQL, ssq};
            pg8::gemm_phase<pg8::EpiConvGate, pg8::OneUnit, false, true>(lds, g, S, E);
        }
#endif
    }
#if MK_CMP7
    if (IN(7)) {
        xcd_barrier(xbar);
        bf16_t* act_ref = (bf16_t*)(ws + 388 * MiB);
        pg8::Gemm g2{Hbuf, WupT, TOK, NUP, 1024};
        for (int id = vcu; id < 65 * 22; id += G) { const int mtile = id / 22, pn = id % 22;
            pg8::OneUnit S1; S1.u0.pm = mtile; S1.u0.pn = pn; S1.u0.arow = 254 * mtile;
            pg8::EpiConvGate E1{act_ref, conv_w, conv_b, 254 * mtile - 1, 0, ssq};
            pg8::gemm_phase<pg8::EpiConvGate, pg8::OneUnit, false, true>(lds, g2, S1, E1); }
        xcd_barrier(xbar);
        unsigned* fl = (unsigned*)(ws + WS_FLAG);
        unsigned cnt[6] = {0u, 0u, 0u, 0u, 0u, 0u};
        for (size_t i = gt; i < (size_t)SEQL * DFF; i += NGT) { const int t = (int)(i / DFF); const int j = t % 254 + 1;
            const float a = bflo((unsigned)act[i]), b = bflo((unsigned)act_ref[i]); const bool bad = !(fabsf(a - b) <= 0.03f * (fabsf(a) + fabsf(b)) + 2e-3f);
            const int cat = (j % 64 == 0 || j % 64 == 63) ? 2 : ((j % 16 == 0 || j % 16 == 15) ? 1 : 0);
            if (cat == 0) { cnt[1]++; cnt[0] += bad; } else if (cat == 1) { cnt[3]++; cnt[2] += bad; } else { cnt[5]++; cnt[4] += bad; } }
#pragma unroll
        for (int k = 0; k < 6; ++k) if (cnt[k]) atomicAdd(fl + 20 + k, cnt[k]);
    }
#endif
    SEAM(7);
    if (IN(8)) {
        pg8::Gemm g{act, WdnT, TOK, 1024, DFF}; pg8::StaticOrder S; S.init(TOK, 1024, G, bx, 0);
        pg8::EpiDown E{H2 + 1024, ln_ffn, Hrow, ssq2};
        pg8::gemm_phase<pg8::EpiDown, pg8::StaticOrder, true, true>(lds, g, S, E);
    }
    SEAM(8);
#if MK_CMP7
    if (IN(9)) { const unsigned* fl = (const unsigned*)(ws + WS_FLAG); int code = 0;
        if ((float)fl[20] > 0.01f * (float)fl[21]) code |= 1; if ((float)fl[22] > 0.01f * (float)fl[23]) code |= 2; if ((float)fl[24] > 0.01f * (float)fl[25]) code |= 4;
        const float v = (float)(2 + code); for (size_t i = gt; i < (size_t)TOK * 1024; i += NGT) out[i] = v; }
#else
    if (IN(9)) { for (int rep9 = 0; rep9 < REP_P9; ++rep9) for (int m = gw; m < TOK; m += 2 * NGW) { const int m2 = m + NGW;
            const bf16_t* ra = Hrow + (size_t)m * 1024; const bf16_t* rb = Hrow + (size_t)m2 * 1024;
            const u32x4 a0 = ((const u32x4*)ra)[lane], a1 = ((const u32x4*)ra)[64 + lane], b0 = ((const u32x4*)rb)[lane], b1 = ((const u32x4*)rb)[64 + lane];
            const float qa = ssq2[m], qb = ssq2[m2];
            rms_row_final_regs(a0, a1, qa, ln_final, out + (size_t)m * 1024, lane); rms_row_final_regs(b0, b1, qb, ln_final, out + (size_t)m2 * 1024, lane); } }
#endif
#undef IN
#undef SEAM
}

extern "C" void kernel_launch(void* const* d_in, const int* in_sizes, int n_in, void* d_out, int out_size, void* d_ws, size_t ws_size, hipStream_t stream) {
    static int grid = 0;
    if (grid == 0) {
        if (n_in != 18 || out_size != TOK * 1024 || ws_size < WS_END) { fprintf(stderr, "kernel_launch: unexpected shapes (n_in %d out %d ws %zu)\n", n_in, out_size, ws_size); grid = -1; return; }
        int dev = 0, cus = 0, per_cu = 0;
        (void)hipGetDevice(&dev); (void)hipDeviceGetAttribute(&cus, hipDeviceAttributeMultiprocessorCount, dev);
        if (hipOccupancyMaxActiveBlocksPerMultiprocessor(&per_cu, (const void*)hymba_fwd, NTHR, 0) != hipSuccess || per_cu < 1) { fprintf(stderr, "kernel_launch: occupancy query says %d\n", per_cu); per_cu = 1; }
        (void)hipGetLastError();
        grid = cus * 1;
        if (grid % 8 != 0 || grid <= 0) grid = 256;
    }
    if (grid < 0) return;
    Args a{};
    for (int i = 0; i < 18; ++i) a.in[i] = (const float*)d_in[i];
    a.out = (float*)d_out; a.ws = (unsigned char*)d_ws;
#if MK_PER_PHASE
    a.chk = -1;
#if MK_DIAG
    (void)hipMemsetAsync((char*)d_ws + WS_FLAG, 0, 128, stream);
#endif
    for (int p = 0; p < 10; ++p) { a.ph_lo = p; a.ph_hi = p + 1; a.chk = -1; hipLaunchKernelGGL(hymba_fwd, dim3(grid), dim3(NTHR), 0, stream, a);
#if MK_DIAG
        if (p <= 8) { a.ph_lo = a.ph_hi = -1; a.chk = p; hipLaunchKernelGGL(hymba_fwd, dim3(grid), dim3(NTHR), 0, stream, a); }
        if (p == 9) { a.ph_lo = a.ph_hi = -1; a.chk = 99; hipLaunchKernelGGL(hymba_fwd, dim3(grid), dim3(NTHR), 0, stream, a); }
#endif
    }
#else
    a.ph_lo = 0; a.ph_hi = 10; a.chk = -1;
    (void)hipMemsetAsync((char*)d_ws + WS_BAR, 0, XCD_BAR_WORDS * 4, stream);
#if MK_CMP7
    (void)hipMemsetAsync((char*)d_ws + WS_FLAG, 0, 256, stream);
#endif
    void* kargs[] = {&a};
    hipError_t e = hipLaunchCooperativeKernel((const void*)hymba_fwd, dim3(grid), dim3(NTHR), kargs, 0, stream);
    if (e != hipSuccess) fprintf(stderr, "kernel_launch: cooperative launch failed: %s (grid %d)\n", hipGetErrorString(e), grid);
#endif
}
```

```cpp
#include <hip/hip_runtime.h>
#include <cstdio>
#include <cstdint>
namespace pg8 {
#define PG8_LAS __attribute__((address_space(3)))
typedef unsigned short bf16_t;
typedef short bf16x8 __attribute__((ext_vector_type(8)));
typedef float f32x4 __attribute__((ext_vector_type(4)));
typedef unsigned u32x4 __attribute__((ext_vector_type(4)));
constexpr int BM = 256, BK = 64, HALF = 128, HTB = HALF * BK * 2  , STAGE_BYTES = 8 * HTB, NXCD = 8, WGM = 8;

__host__ __device__ __forceinline__ int lds_byte(int r, int c) { const int st = (r >> 4) * 2 + (c >> 5), rr = r & 15, cc = c & 31, ob = rr * 64 + cc * 2; return st * 1024 + (ob ^ (((ob >> 9) & 1) << 5)); }
__host__ __device__ __forceinline__ void stage_rc(int b, int& R, int& C) { const int st = b / 1024, sb = b % 1024, swz = sb ^ (((sb >> 9) & 1) << 5); R = (st >> 1) * 16 + swz / 64; C = (st & 1) * 32 + (swz % 64) / 2; }
__host__ __device__ __forceinline__ int perm32(int rho) { const int n = rho >> 4, i = rho & 15; return 8 * (i >> 2) + 4 * n + (i & 3); }

struct Unit { int pm, pn, arow; };
struct Gemm { const bf16_t* A; const bf16_t* Bt; int M, N, K; };

struct StaticOrder {
    int nM, nN, nwg, G, c, aoff;
    __host__ __device__ void init(int M, int N, int G_, int c_, int aoff_) { nM = M / BM; nN = N / BM; nwg = nM * nN; G = G_; c = c_; aoff = aoff_; }
    __host__ __device__ bool next(int i, Unit& u) const {
        const long L = (long)i * G + c; if (L >= nwg) return false;
        int wgid = (int)L; { const int q = nwg / NXCD, r = nwg % NXCD, xcd = wgid % NXCD, off = wgid / NXCD; wgid = (xcd < r ? xcd * (q + 1) : r * (q + 1) + (xcd - r) * q) + off; }
        const int nig = WGM * nN, gid = wgid / nig, fm = gid * WGM, gsz = (nM - fm) < WGM ? (nM - fm) : WGM;
        u.pm = fm + ((wgid % nig) % gsz); u.pn = (wgid % nig) / gsz; u.arow = aoff + u.pm * BM; return true;
    }
    __device__ __forceinline__ void a_ready(const Unit&) const {}
    __device__ __forceinline__ void done(const Unit&) const {}
};

typedef float f32x2c __attribute__((ext_vector_type(2))); typedef __bf16 bf16x2c __attribute__((ext_vector_type(2)));
__device__ __forceinline__ unsigned cvt_pk_bf16(float lo, float hi) { const f32x2c v = {lo, hi}; const bf16x2c b = __builtin_convertvector(v, bf16x2c); return __builtin_bit_cast(unsigned, b); }
typedef float f32x2 __attribute__((ext_vector_type(2)));
__device__ __forceinline__ f32x2 gelu_pk(f32x2 v) {
    const f32x2 av = __builtin_elementwise_abs(v), d = av * 0.2316418882f + 1.0f;
    f32x2 t; t.x = __builtin_amdgcn_rcpf(d.x); t.y = __builtin_amdgcn_rcpf(d.y);
    f32x2 q = t * 0.5307027145f + (-0.7265760135f); q = q * t + 0.7107068705f; q = q * t + (-0.142248368f); q = q * t + 0.127414796f; q = q * t;
    const f32x2 s = (v * v) * (-0.72134752044f);
    f32x2 e; e.x = __builtin_amdgcn_exp2f(s.x); e.y = __builtin_amdgcn_exp2f(s.y);
    const f32x2 m = v * (q * e), r = v - m;
    f32x2 o; o.x = v.x < 0.f ? m.x : r.x; o.y = v.y < 0.f ? m.y : r.y; return o;
}

template <int ACT  > struct EpiBf16 {
    static constexpr bool PERM = true, AFTER_DRAIN = false, APERM = false; static_assert(ACT == 0 || ACT == 1, "EpiBf16: ACT is 0 (none) or 1 (gelu_pk)");
    bf16_t* O; int ldc; const float* bias; int split_cols; size_t split_stride; float scale0;
    __device__ __forceinline__ void operator()(const f32x4 (&acc)[2][2][4][2], const Unit& u, int wr, int wc, int fr, int fq) const {
        const int row0 = u.pm * BM + wr * 64 + fr; int colt = u.pn * BM; bf16_t* base = O;
        float sc = 1.f; if (split_cols) { const int t = colt / split_cols; base += (size_t)t * split_stride; colt -= t * split_cols; if (t == 0) sc = scale0; }
        const int col0 = colt + wc * 32 + 8 * fq, bcol0 = u.pn * BM + wc * 32 + 8 * fq;
        f32x4 bv[2][2];
#pragma unroll
        for (int bj = 0; bj < 2; ++bj)
#pragma unroll
            for (int n = 0; n < 2; ++n) bv[bj][n] = bias ? *(const f32x4*)(bias + bcol0 + bj * HALF + 4 * n) : (f32x4){0.f, 0.f, 0.f, 0.f};
#pragma unroll
        for (int ai = 0; ai < 2; ++ai)
#pragma unroll
            for (int m = 0; m < 4; ++m) { bf16_t* rowp = base + (size_t)(row0 + ai * HALF + m * 16) * ldc + col0;
#pragma unroll
                for (int bj = 0; bj < 2; ++bj) { f32x4 v0 = acc[ai][bj][m][0] + bv[bj][0], v1 = acc[ai][bj][m][1] + bv[bj][1];
                    if (ACT == 1) { f32x2 a = gelu_pk((f32x2){v0[0], v0[1]}), b = gelu_pk((f32x2){v0[2], v0[3]}), c = gelu_pk((f32x2){v1[0], v1[1]}), d = gelu_pk((f32x2){v1[2], v1[3]});
                        v0 = (f32x4){a.x, a.y, b.x, b.y}; v1 = (f32x4){c.x, c.y, d.x, d.y}; }
                    v0 = v0 * sc; v1 = v1 * sc; u32x4 w; w.x = cvt_pk_bf16(v0[0], v0[1]); w.y = cvt_pk_bf16(v0[2], v0[3]); w.z = cvt_pk_bf16(v1[0], v1[1]); w.w = cvt_pk_bf16(v1[2], v1[3]);
                    *(u32x4*)(rowp + bj * HALF) = w; } }
    }
};
struct EpiResid {
    static constexpr bool PERM = false, AFTER_DRAIN = false, APERM = false;
    const float* base0; const float* base1; int split_row; float* out;
    __device__ __forceinline__ void operator()(const f32x4 (&acc)[2][2][4][2], const Unit& u, int wr, int wc, int fr, int fq) const {
#pragma unroll
        for (int ai = 0; ai < 2; ++ai)
#pragma unroll
            for (int m = 0; m < 4; ++m) {
                const int row = u.pm * BM + ai * HALF + wr * 64 + m * 16 + fr;
                const float* bp = row < split_row ? base0 + (size_t)row * 1024 : base1 + (size_t)(row - split_row) * 1024;
                float* op = out + (size_t)row * 1024;
#pragma unroll
                for (int bj = 0; bj < 2; ++bj)
#pragma unroll
                    for (int n = 0; n < 2; ++n) { const int col = u.pn * BM + bj * HALF + wc * 32 + n * 16 + fq * 4;
                        const f32x4 b = *(const f32x4*)(bp + col); *(f32x4*)(op + col) = b + acc[ai][bj][m][n]; }
            }
    }
};
struct EpiResidNorm {
    static constexpr bool PERM = true, AFTER_DRAIN = false, APERM = false;
    const float* base0; const float* base1; int split_row; float* out; bf16_t* h2; const float* ln; float* ssq;
    __device__ __forceinline__ void operator()(const f32x4 (&acc)[2][2][4][2], const Unit& u, int wr, int wc, int fr, int fq) const {
        typedef unsigned u32x4v __attribute__((ext_vector_type(4)));
#pragma unroll
        for (int ai = 0; ai < 2; ++ai)
#pragma unroll
            for (int m = 0; m < 4; ++m) {
                const int row = u.pm * BM + ai * HALF + wr * 64 + m * 16 + fr;
                const float* bp = row < split_row ? base0 + (size_t)row * 1024 : base1 + (size_t)(row - split_row) * 1024;
                bf16_t* hp = h2 + (size_t)row * 1024; float s = 0.f;
#pragma unroll
                for (int bj = 0; bj < 2; ++bj) { const int col = u.pn * BM + bj * HALF + wc * 32 + fq * 8;
                    const f32x4 x0 = *(const f32x4*)(bp + col) + acc[ai][bj][m][0], x1 = *(const f32x4*)(bp + col + 4) + acc[ai][bj][m][1];
                    const f32x4 g0 = *(const f32x4*)(ln + col), g1 = *(const f32x4*)(ln + col + 4);
                    s += ((x0[0] * x0[0] + x0[1] * x0[1]) + (x0[2] * x0[2] + x0[3] * x0[3])) + ((x1[0] * x1[0] + x1[1] * x1[1]) + (x1[2] * x1[2] + x1[3] * x1[3]));
                    u32x4v w; w.x = cvt_pk_bf16(x0[0] * g0[0], x0[1] * g0[1]); w.y = cvt_pk_bf16(x0[2] * g0[2], x0[3] * g0[3]); w.z = cvt_pk_bf16(x1[0] * g1[0], x1[1] * g1[1]); w.w = cvt_pk_bf16(x1[2] * g1[2], x1[3] * g1[3]);
                    *(u32x4v*)(hp + col) = w; }
                s += __shfl_xor(s, 16); s += __shfl_xor(s, 32);
                if (fq == 0) atomicAdd(ssq + row, s);
            }
    }
};
struct EpiDown {
    static constexpr bool PERM = true, AFTER_DRAIN = false, APERM = false;
    const bf16_t* h2; const float* ln; bf16_t* x2b; float* ssq2;
    __device__ __forceinline__ void operator()(const f32x4 (&acc)[2][2][4][2], const Unit& u, int wr, int wc, int fr, int fq) const {
        typedef unsigned u32x4v __attribute__((ext_vector_type(4)));
#pragma unroll
        for (int ai = 0; ai < 2; ++ai)
#pragma unroll
            for (int m = 0; m < 4; ++m) {
                const int row = u.pm * BM + ai * HALF + wr * 64 + m * 16 + fr;
                const bf16_t* hp = h2 + (size_t)row * 1024; bf16_t* op = x2b + (size_t)row * 1024; float s = 0.f;
#pragma unroll
                for (int bj = 0; bj < 2; ++bj) { const int col = u.pn * BM + bj * HALF + wc * 32 + fq * 8;
                    const u32x4v hw = *(const u32x4v*)(hp + col); const f32x4 g0 = *(const f32x4*)(ln + col), g1 = *(const f32x4*)(ln + col + 4);
                    f32x4 x0, x1;
                    x0[0] = __uint_as_float(hw.x << 16) / g0[0]; x0[1] = __uint_as_float(hw.x & 0xffff0000u) / g0[1]; x0[2] = __uint_as_float(hw.y << 16) / g0[2]; x0[3] = __uint_as_float(hw.y & 0xffff0000u) / g0[3];
                    x1[0] = __uint_as_float(hw.z << 16) / g1[0]; x1[1] = __uint_as_float(hw.z & 0xffff0000u) / g1[1]; x1[2] = __uint_as_float(hw.w << 16) / g1[2]; x1[3] = __uint_as_float(hw.w & 0xffff0000u) / g1[3];
                    x0 += acc[ai][bj][m][0]; x1 += acc[ai][bj][m][1];
                    s += ((x0[0] * x0[0] + x0[1] * x0[1]) + (x0[2] * x0[2] + x0[3] * x0[3])) + ((x1[0] * x1[0] + x1[1] * x1[1]) + (x1[2] * x1[2] + x1[3] * x1[3]));
                    u32x4v w; w.x = cvt_pk_bf16(x0[0], x0[1]); w.y = cvt_pk_bf16(x0[2], x0[3]); w.z = cvt_pk_bf16(x1[0], x1[1]); w.w = cvt_pk_bf16(x1[2], x1[3]); *(u32x4v*)(op + col) = w; }
                s += __shfl_xor(s, 16); s += __shfl_xor(s, 32);
                if (fq == 0) atomicAdd(ssq2 + row, s);
            }
    }
};
struct EpiConvGate {
    static constexpr bool PERM = false, AFTER_DRAIN = true, APERM = false;
    bf16_t* act; const float* cw; const float* cb; int tt0; int tokbase; const float* ssq;
    __device__ __forceinline__ void fused(f32x4 (&acc)[2][2][4][2], const Unit& u, int wr, int wc, int fr, int fq, PG8_LAS unsigned char* lds, int wid, int lane) const {
        constexpr int ROWB = 528, SEQL = 16384, NUP = 5632, DFF = 2816;
        typedef unsigned u32x2 __attribute__((ext_vector_type(2)));
        f32x4 wa[2][4], wg[2][4];
#pragma unroll
        for (int n = 0; n < 1; ++n) { const int ca = u.pn * HALF + wc * 32 + n * 16 + fq * 4, cg = DFF + ca;
#pragma unroll
            for (int k = 0; k < 3; ++k) { wa[n][k] = *(const f32x4*)(cw + k * NUP + ca); wg[n][k] = *(const f32x4*)(cw + k * NUP + cg); }
            wa[n][3] = *(const f32x4*)(cb + ca); wg[n][3] = *(const f32x4*)(cb + cg); }
#pragma unroll
        for (int ai = 0; ai < 2; ++ai)
#pragma unroll
            for (int m = 0; m < 4; ++m) {
                const int j = ai * HALF + wr * 64 + m * 16 + fr; const bool valid = (unsigned)(tt0 + j) < (unsigned)SEQL;
                const float q = ssq[valid ? tokbase + tt0 + j : 0]; const float rs = valid ? 1.0f / sqrtf(q * (1.0f / 1024.0f) + 1e-6f) : 0.f;
#pragma unroll
                for (int bj = 0; bj < 2; ++bj)
#pragma unroll
                    for (int n = 0; n < 2; ++n) { const f32x4 v = acc[ai][bj][m][n] * rs; acc[ai][bj][m][n] = v;
                        u32x2 w; w.x = cvt_pk_bf16(v[0], v[1]); w.y = cvt_pk_bf16(v[2], v[3]);
                        *(PG8_LAS u32x2*)(lds + j * ROWB + (bj * HALF + wc * 32 + n * 16 + fq * 4) * 2) = w; }
            }
        __syncthreads();
#pragma unroll
        for (int n = 0; n < 2; ++n) {
            const int j0 = wc * 32 + n * 16 + fq * 4, ca = u.pn * HALF + j0, cg = DFF + ca;
            if (n == 1) {
#pragma unroll
                for (int k = 0; k < 3; ++k) { wa[1][k] = *(const f32x4*)(cw + k * NUP + ca); wg[1][k] = *(const f32x4*)(cw + k * NUP + cg); }
                wa[1][3] = *(const f32x4*)(cb + ca); wg[1][3] = *(const f32x4*)(cb + cg); }
            const f32x4 wa0 = wa[n][0], wa1 = wa[n][1], wa2 = wa[n][2], ba = wa[n][3], wg0 = wg[n][0], wg1 = wg[n][1], wg2 = wg[n][2], bg = wg[n][3];
#pragma unroll
            for (int ai = 0; ai < 2; ++ai)
#pragma unroll
                for (int m = 0; m < 4; ++m) {
                    const int j = ai * HALF + wr * 64 + m * 16 + fr; const int tt = tt0 + j;
                    if (j >= 1 && j <= 254 && tt < SEQL) {
                        const u32x2 ua = *(const PG8_LAS u32x2*)(lds + (j - 1) * ROWB + j0 * 2), da = *(const PG8_LAS u32x2*)(lds + (j + 1) * ROWB + j0 * 2);
                        const u32x2 ug = *(const PG8_LAS u32x2*)(lds + (j - 1) * ROWB + (HALF + j0) * 2), dg = *(const PG8_LAS u32x2*)(lds + (j + 1) * ROWB + (HALF + j0) * 2);
                        const f32x4 upa = {__uint_as_float(ua.x << 16), __uint_as_float(ua.x & 0xffff0000u), __uint_as_float(ua.y << 16), __uint_as_float(ua.y & 0xffff0000u)};
                        const f32x4 dna = {__uint_as_float(da.x << 16), __uint_as_float(da.x & 0xffff0000u), __uint_as_float(da.y << 16), __uint_as_float(da.y & 0xffff0000u)};
                        const f32x4 upg = {__uint_as_float(ug.x << 16), __uint_as_float(ug.x & 0xffff0000u), __uint_as_float(ug.y << 16), __uint_as_float(ug.y & 0xffff0000u)};
                        const f32x4 dng = {__uint_as_float(dg.x << 16), __uint_as_float(dg.x & 0xffff0000u), __uint_as_float(dg.y << 16), __uint_as_float(dg.y & 0xffff0000u)};
                        const f32x4 a = wa0 * upa + wa1 * acc[ai][0][m][n] + wa2 * dna + ba;
                        const f32x4 g = wg0 * upg + wg1 * acc[ai][1][m][n] + wg2 * dng + bg;
                        f32x4 r;
#pragma unroll
                        for (int i = 0; i < 4; ++i) r[i] = a[i] * g[i] * __builtin_amdgcn_rcpf(1.0f + __expf(-g[i]));
                        u32x2 w; w.x = cvt_pk_bf16(r[0], r[1]); w.y = cvt_pk_bf16(r[2], r[3]);
                        *(u32x2*)(act + (size_t)(tokbase + tt) * DFF + ca) = w;
                    }
                }
        }
        __syncthreads();
    }
};
struct OneUnit {
    Unit u0;
    __device__ __forceinline__ bool next(int i, Unit& u) const { if (i != 0) return false; u = u0; return true; }
    __device__ __forceinline__ void a_ready(const Unit&) const {}
    __device__ __forceinline__ void done(const Unit&) const {}
};

template <bool SHR> __device__ __forceinline__ f32x4 dppn(const f32x4 x, const f32x4 e) { f32x4 r;
#pragma unroll
    for (int i = 0; i < 4; ++i) { const float xf = x[i], ef = e[i]; const int xi = __float_as_int(xf), ei = __float_as_int(ef);
        const int mir = __builtin_amdgcn_update_dpp(0, ei, 0x140, 0xf, 0xf, true);
        const int o = __builtin_amdgcn_update_dpp(mir, xi, SHR ? 0x111 : 0x101, 0xf, 0xf, false);
        r[i] = __int_as_float(o); }
    return r; }
struct UpOrder {
    int G, vcu;
    __device__ __forceinline__ bool next(int i, Unit& u) const { const int id = i * G + vcu; if (id >= 3 * 65 * 22) return false;
        const int mt = id / 22; u.pm = mt; u.pn = id - mt * 22; u.arow = (mt / 65) * 16384 + 254 * (mt % 65); return true; }
    __device__ __forceinline__ void a_ready(const Unit&) const {}
    __device__ __forceinline__ void done(const Unit&) const {}
};
template <bool SHR> __device__ __forceinline__ f32x4 dpps(const f32x4 x, const f32x4 old) { f32x4 r;
#pragma unroll
    for (int i = 0; i < 4; ++i) { const float xf = x[i], of = old[i];
        r[i] = __int_as_float(__builtin_amdgcn_update_dpp(__float_as_int(of), __float_as_int(xf), SHR ? 0x111 : 0x101, 0xf, 0xf, false)); }
    return r; }
struct EpiConvGate2 {
    static constexpr bool PERM = true, AFTER_DRAIN = false, APERM = true;
    bf16_t* act; const float* cw; const float* cb; PG8_LAS float* bnd; const float* ssq;
    __device__ __forceinline__ void operator()(f32x4 (&acc)[2][2][4][2], const Unit& u, int wr, int wc, int fr, int fq) const {
        constexpr int SEQL = 16384, NUP = 5632, DFF = 2816;
        typedef unsigned u32x2 __attribute__((ext_vector_type(2)));
        typedef unsigned u32x4v __attribute__((ext_vector_type(4)));
        const f32x4 zero4 = {0.f, 0.f, 0.f, 0.f};
        const int tt0 = 254 * (u.pm % 65) - 1, tokbase = (u.pm / 65) * SEQL;
        u32x2 keep[2][4];
        f32x4 wa[4], wg[4];
        { const int ca = u.pn * HALF + wc * 32 + fq * 8, cg = DFF + ca;
#pragma unroll
            for (int k = 0; k < 3; ++k) { wa[k] = *(const f32x4*)(cw + k * NUP + ca); wg[k] = *(const f32x4*)(cw + k * NUP + cg); }
            wa[3] = *(const f32x4*)(cb + ca); wg[3] = *(const f32x4*)(cb + cg); }
#pragma unroll
        for (int ai = 0; ai < 2; ++ai)
#pragma unroll
            for (int m = 0; m < 4; ++m) { const int tt = tt0 + ai * HALF + wr * 64 + 4 * fr + m; const bool valid = (unsigned)tt < (unsigned)SEQL;
                const float q = ssq[valid ? tokbase + tt : 0]; const float rs = valid ? 1.0f / sqrtf(q * (1.0f / 1024.0f) + 1e-6f) : 0.f;
#pragma unroll
                for (int bj = 0; bj < 2; ++bj)
#pragma unroll
                    for (int n = 0; n < 2; ++n) acc[ai][bj][m][n] *= rs; }
#pragma unroll
        for (int ai = 0; ai < 2; ++ai) { const int blk = ai * 2 + wr;
#pragma unroll
            for (int bj = 0; bj < 2; ++bj)
#pragma unroll
                for (int n = 0; n < 2; ++n) { const int col = bj * HALF + wc * 32 + fq * 8 + n * 4;
                    if (fr == 0) *(PG8_LAS f32x4*)(bnd + (blk * 2 + 0) * 256 + col) = acc[ai][bj][0][n];
                    if (fr == 15) *(PG8_LAS f32x4*)(bnd + (blk * 2 + 1) * 256 + col) = acc[ai][bj][3][n]; } }
        asm volatile("s_waitcnt lgkmcnt(0)" ::: "memory"); __builtin_amdgcn_s_barrier(); asm volatile("" ::: "memory");
#pragma unroll
        for (int n = 0; n < 2; ++n) {
            const int j0 = wc * 32 + fq * 8 + n * 4, ca = u.pn * HALF + j0, cg = DFF + ca;
            if (n == 1) {
#pragma unroll
                for (int k = 0; k < 3; ++k) { wa[k] = *(const f32x4*)(cw + k * NUP + ca); wg[k] = *(const f32x4*)(cw + k * NUP + cg); }
                wa[3] = *(const f32x4*)(cb + ca); wg[3] = *(const f32x4*)(cb + cg); }
#pragma unroll
            for (int ai = 0; ai < 2; ++ai) { const int blk = ai * 2 + wr;
                f32x4 upe[2], dne[2];
#pragma unroll
                for (int bj = 0; bj < 2; ++bj) { const int col = bj * HALF + j0;
                    const f32x4 abv = blk > 0 ? *(const PG8_LAS f32x4*)(bnd + ((blk - 1) * 2 + 1) * 256 + col) : zero4;
                    const f32x4 blw = blk < 3 ? *(const PG8_LAS f32x4*)(bnd + ((blk + 1) * 2 + 0) * 256 + col) : zero4;
                    upe[bj] = dpps<true>(acc[ai][bj][3][n], abv); dne[bj] = dpps<false>(acc[ai][bj][0][n], blw); }
#pragma unroll
                for (int m = 0; m < 4; ++m) {
                    const int j = ai * HALF + wr * 64 + 4 * fr + m, tt = tt0 + j;
                    f32x4 cv[2];
#pragma unroll
                    for (int bj = 0; bj < 2; ++bj) {
                        const f32x4 X = acc[ai][bj][m][n];
                        const f32x4 up = m > 0 ? acc[ai][bj][m > 0 ? m - 1 : 0][n] : upe[bj];
                        const f32x4 dn = m < 3 ? acc[ai][bj][m < 3 ? m + 1 : 3][n] : dne[bj];
                        cv[bj] = bj == 0 ? (wa[0] * up + wa[1] * X + wa[2] * dn + wa[3]) : (wg[0] * up + wg[1] * X + wg[2] * dn + wg[3]);
                    }
                    if (j >= 1 && j <= 254 && tt < SEQL) {
                        f32x4 r;
#pragma unroll
                        for (int i = 0; i < 4; ++i) r[i] = cv[0][i] * cv[1][i] * __builtin_amdgcn_rcpf(1.0f + __expf(-cv[1][i]));
                        u32x2 w; w.x = cvt_pk_bf16(r[0], r[1]); w.y = cvt_pk_bf16(r[2], r[3]);
                        if (n == 0) keep[ai][m] = w;
                        else __builtin_nontemporal_store((u32x4v){keep[ai][m].x, keep[ai][m].y, w.x, w.y}, (u32x4v*)(act + (size_t)(tokbase + tt) * DFF + ca - 4));
                    }
                }
            }
        }
    }
};
template <class Epi, class Sched, bool ALIGN_EPI = false, bool SP2 = false>
__device__ __forceinline__ void gemm_phase(PG8_LAS unsigned char* lds, const Gemm g, const Sched& S, const Epi& E) {
    const int tid = threadIdx.x, wid = __builtin_amdgcn_readfirstlane(tid >> 6), lane = tid & 63, wr = wid >> 2, wc = wid & 3, fr = lane & 15, fq = lane >> 4;
    const int K = g.K, nt = K / BK;
    unsigned voffA[2], voffB[2];
#pragma unroll
    for (int i = 0; i < 2; ++i) { int R, C; stage_rc(tid * 16 + i * 8192, R, C); const int Rb = Epi::PERM ? ((R & ~31) + perm32(R & 31)) : R;
        const int Ra = Epi::APERM ? ((R & 64) + 4 * (R & 15) + ((R >> 4) & 3)) : R;
        voffA[i] = (unsigned)(Ra * K + C) * 2u; voffB[i] = (unsigned)(Rb * K + C) * 2u; }
    const size_t kstep = (size_t)(BK * 2);
    const size_t hstep = (size_t)HALF * K * 2;
    const size_t tstep = 2 * hstep;
    const unsigned ldsw = (unsigned)wid * 1024u;
    const int aoff = lds_byte(wr * 64 + fr, fq * 8), boff = lds_byte(wc * 32 + fr, fq * 8);
#define PG8_SA(b, h) (((b) * 2 + (h)) * HTB)
#define PG8_SB(b, h) ((4 + (b) * 2 + (h)) * HTB)
#define PG8_STAGE(bufoff, gbase, voff) do { _Pragma("unroll") for (int _i = 0; _i < 2; ++_i) \
        __builtin_amdgcn_global_load_lds((const unsigned*)((const char*)(gbase) + (voff)[_i]), (PG8_LAS unsigned*)(lds + (bufoff) + ldsw + _i * 8192), 16, 0, 0); } while (0)
#define PG8_LDA(dst, b, h) do { _Pragma("unroll") for (int m = 0; m < 4; ++m) _Pragma("unroll") for (int k = 0; k < 2; ++k) dst[m][k] = *(const PG8_LAS bf16x8*)(lds + PG8_SA(b, h) + aoff + m * 2048 + k * 1024); } while (0)
#define PG8_LDB(dst, b, h) do { _Pragma("unroll") for (int n = 0; n < 2; ++n) _Pragma("unroll") for (int k = 0; k < 2; ++k) dst[n][k] = *(const PG8_LAS bf16x8*)(lds + PG8_SB(b, h) + boff + n * 2048 + k * 1024); } while (0)
#define PG8_MMA(ai, bj, At, Bt) do { __builtin_amdgcn_s_setprio(1); _Pragma("unroll") for (int m = 0; m < 4; ++m) _Pragma("unroll") for (int n = 0; n < 2; ++n) _Pragma("unroll") for (int k = 0; k < 2; ++k) \
        acc[ai][bj][m][n] = __builtin_amdgcn_mfma_f32_16x16x32_bf16(Bt[n][k], At[m][k], acc[ai][bj][m][n], 0, 0, 0); __builtin_amdgcn_s_setprio(0); } while (0)
#define PG8_WAIT_V(n) asm volatile("s_waitcnt vmcnt(" #n ")" ::: "memory")
#define PG8_WAIT_L(n) asm volatile("s_waitcnt lgkmcnt(" #n ")" ::: "memory")
#define PG8_BAR __builtin_amdgcn_s_barrier()
#define PG8_SCHED __builtin_amdgcn_sched_barrier(0)
    Unit cur, nxt; int ui = 0;
    if (!S.next(0, cur)) return;
    f32x4 acc[2][2][4][2];
#pragma unroll
    for (int a = 0; a < 2; ++a)
#pragma unroll
        for (int b = 0; b < 2; ++b)
#pragma unroll
            for (int m = 0; m < 4; ++m)
#pragma unroll
                for (int n = 0; n < 2; ++n) acc[a][b][m][n] = (f32x4){0.f, 0.f, 0.f, 0.f};
    bf16x8 At[4][2], B0[2][2], B1[2][2];
    const char* cA = (const char*)g.A + (size_t)cur.arow * (size_t)K * 2; const char* cB = (const char*)g.Bt + (size_t)cur.pn * tstep;
    S.a_ready(cur);
    if constexpr (SP2) {
        PG8_STAGE(PG8_SB(0, 0), cB, voffB); PG8_STAGE(PG8_SB(0, 1), cB + hstep, voffB); PG8_STAGE(PG8_SA(0, 0), cA, voffA); PG8_STAGE(PG8_SA(0, 1), cA + hstep, voffA);
        if (wr == 1) PG8_BAR;
        PG8_WAIT_V(2); PG8_BAR;
        PG8_STAGE(PG8_SB(1, 0), cB + kstep, voffB); PG8_STAGE(PG8_SA(1, 0), cA + kstep, voffA); PG8_STAGE(PG8_SB(1, 1), cB + hstep + kstep, voffB);
        PG8_WAIT_V(6); PG8_BAR;
    } else {
        PG8_STAGE(PG8_SB(0, 0), cB, voffB); PG8_STAGE(PG8_SA(0, 0), cA, voffA); PG8_STAGE(PG8_SB(0, 1), cB + hstep, voffB); PG8_STAGE(PG8_SA(0, 1), cA + hstep, voffA);
        if (wr == 1) PG8_BAR;
        PG8_WAIT_V(4); PG8_BAR;
        PG8_STAGE(PG8_SB(1, 0), cB + kstep, voffB); PG8_STAGE(PG8_SA(1, 0), cA + kstep, voffA); PG8_STAGE(PG8_SB(1, 1), cB + hstep + kstep, voffB);
        PG8_WAIT_V(6); PG8_BAR;
    }
    for (;;) {
        const bool has_next = S.next(ui + 1, nxt);
        const char* nA = has_next ? (const char*)g.A + (size_t)nxt.arow * (size_t)K * 2 : cA; const char* nB = has_next ? (const char*)g.Bt + (size_t)nxt.pn * tstep : cB;
        for (int t = 0; t < nt; t += 2) {
            const bool last = (t == nt - 2);
            const char* a1 = cA + (size_t)(t + 1) * kstep;
            const char* a2 = last ? nA : cA + (size_t)(t + 2) * kstep; const char* b2 = last ? nB : cB + (size_t)(t + 2) * kstep;
            const char* a3 = a2 + kstep; const char* b3 = b2 + kstep;
            if (last && has_next) S.a_ready(nxt);
            if constexpr (SP2) {
            PG8_LDB(B0, 0, 0); PG8_LDB(B1, 0, 1); PG8_SCHED; PG8_LDA(At, 0, 0); PG8_STAGE(PG8_SA(1, 1), a1 + hstep, voffA);
            PG8_WAIT_V(8); PG8_WAIT_L(0); PG8_BAR; PG8_MMA(0, 0, At, B0); PG8_MMA(0, 1, At, B1); PG8_BAR; PG8_SCHED;
            PG8_LDA(At, 0, 1); PG8_STAGE(PG8_SB(0, 0), b2, voffB); PG8_STAGE(PG8_SB(0, 1), b2 + hstep, voffB); PG8_STAGE(PG8_SA(0, 0), a2, voffA);
            PG8_WAIT_V(8); PG8_WAIT_L(0); PG8_BAR; PG8_MMA(1, 0, At, B0); PG8_MMA(1, 1, At, B1); PG8_BAR; PG8_SCHED;
            PG8_LDB(B0, 1, 0); PG8_LDB(B1, 1, 1); PG8_SCHED; PG8_LDA(At, 1, 0); PG8_STAGE(PG8_SA(0, 1), a2 + hstep, voffA);
            PG8_WAIT_V(8); PG8_WAIT_L(0); PG8_BAR; PG8_MMA(0, 0, At, B0); PG8_MMA(0, 1, At, B1); PG8_BAR; PG8_SCHED;
            PG8_LDA(At, 1, 1); PG8_STAGE(PG8_SB(1, 0), b3, voffB); PG8_STAGE(PG8_SB(1, 1), b3 + hstep, voffB); PG8_STAGE(PG8_SA(1, 0), a3, voffA);
            PG8_WAIT_V(8); PG8_WAIT_L(0); PG8_BAR; PG8_MMA(1, 0, At, B0); PG8_MMA(1, 1, At, B1); PG8_BAR; PG8_SCHED;
            } else {
            PG8_LDB(B0, 0, 0); PG8_SCHED; PG8_LDA(At, 0, 0); PG8_STAGE(PG8_SA(1, 1), a1 + hstep, voffA);
            PG8_WAIT_L(8); PG8_BAR; PG8_WAIT_L(0); PG8_MMA(0, 0, At, B0); PG8_BAR; PG8_SCHED;
            PG8_LDB(B1, 0, 1); PG8_STAGE(PG8_SB(0, 0), b2, voffB);
            PG8_BAR; PG8_WAIT_L(0); PG8_MMA(0, 1, At, B1); PG8_BAR;
            PG8_LDA(At, 0, 1); PG8_STAGE(PG8_SA(0, 0), a2, voffA);
            PG8_BAR; PG8_WAIT_L(0); PG8_MMA(1, 0, At, B0); PG8_BAR; PG8_SCHED;
            PG8_STAGE(PG8_SB(0, 1), b2 + hstep, voffB);
            PG8_WAIT_V(6); PG8_BAR; PG8_MMA(1, 1, At, B1); PG8_BAR;
            PG8_LDB(B0, 1, 0); PG8_SCHED; PG8_LDA(At, 1, 0); PG8_STAGE(PG8_SA(0, 1), a2 + hstep, voffA);
            PG8_WAIT_L(8); PG8_BAR; PG8_WAIT_L(0); PG8_MMA(0, 0, At, B0); PG8_BAR; PG8_SCHED;
            PG8_LDB(B1, 1, 1); PG8_STAGE(PG8_SB(1, 0), b3, voffB);
            PG8_BAR; PG8_WAIT_L(0); PG8_MMA(0, 1, At, B1); PG8_BAR;
            PG8_LDA(At, 1, 1); PG8_STAGE(PG8_SA(1, 0), a3, voffA);
            PG8_BAR; PG8_WAIT_L(0); PG8_MMA(1, 0, At, B0); PG8_BAR; PG8_SCHED;
            PG8_STAGE(PG8_SB(1, 1), b3 + hstep, voffB);
            PG8_WAIT_V(6); PG8_BAR; PG8_MMA(1, 1, At, B1); PG8_BAR;
            }
        }
        if constexpr (ALIGN_EPI) { if (wr == 0) PG8_BAR; }
        if constexpr (!Epi::AFTER_DRAIN) { E(acc, cur, wr, wc, fr, fq); S.done(cur); }
        if (!has_next) break;
#pragma unroll
        for (int a = 0; a < 2; ++a)
#pragma unroll
            for (int b = 0; b < 2; ++b)
#pragma unroll
                for (int m = 0; m < 4; ++m)
#pragma unroll
                    for (int n = 0; n < 2; ++n) acc[a][b][m][n] = (f32x4){0.f, 0.f, 0.f, 0.f};
        cur = nxt; cA = nA; cB = nB; ++ui;
        if constexpr (ALIGN_EPI) { if (wr == 1) PG8_BAR; }
    }
    PG8_WAIT_V(0);
    if constexpr (!ALIGN_EPI) { if (wr == 0) PG8_BAR; }
    PG8_BAR;
    if constexpr (Epi::AFTER_DRAIN) { E.fused(acc, cur, wr, wc, fr, fq, lds, wid, lane); S.done(cur); }
#undef PG8_SA
#undef PG8_SB
#undef PG8_STAGE
#undef PG8_LDA
#undef PG8_LDB
#undef PG8_MMA
#undef PG8_WAIT_V
#undef PG8_WAIT_L
#undef PG8_BAR
#undef PG8_SCHED
}
}
#include <hip/hip_bf16.h>
#include <cmath>
namespace attn_body {
using bf16=__hip_bfloat16;
using bf16x8=__attribute__((ext_vector_type(8)))short;
using s16x4=__attribute__((ext_vector_type(4)))short;
using f32x16=__attribute__((ext_vector_type(16)))float;
using u32x4=__attribute__((ext_vector_type(4)))unsigned;
constexpr int SEQ=16384,D=64,DM=2560,OPITCH=1024;
constexpr int NW=8,QBLK=32,QB=QBLK*NW,KVBLK=64,NQB=SEQ/QB;
constexpr int ATTN_UNIT_ROWS=QB;
__device__ __forceinline__ int crow(int r,int hi){return (r&3)+8*(r>>2)+4*hi;}
#define SBAR() __builtin_amdgcn_sched_barrier(0)
__device__ __forceinline__ void cmask(f32x16&p0,f32x16&p1,int jb,int qrel,int hi){
  const float NEG=-INFINITY; int kb=64*jb+4*hi;
  #pragma unroll
  for(int r=0;r<16;++r){int kv=kb+(r&3)+8*(r>>2); if(kv>qrel)p0[r]=NEG; if(kv+32>qrel)p1[r]=NEG;}
}

constexpr int NSLOT=3, SLOTB=8192;
constexpr int LDS_K=0, LDS_V=NSLOT*SLOTB, LDS_WS=2*NSLOT*SLOTB, LDS_OST=LDS_WS+NW*64*4, LDS_BYTES=LDS_OST+NW*4096;
constexpr float C2=0.125f*1.4426950408889634f;
__device__ __forceinline__ void glds16(const void*gsrc,unsigned lds_dst){unsigned keep;
  asm volatile("s_mov_b32 %0, m0\n\ts_mov_b32 m0, %2\n\ts_nop 0\n\tglobal_load_lds_dwordx4 %1, off\n\ts_mov_b32 m0, %0":"=&s"(keep):"v"(gsrc),"s"(lds_dst):"memory");}
__device__ __forceinline__ float max3f(float a,float b,float c){float r;asm("v_max3_f32 %0, %1, %2, %3":"=v"(r):"v"(a),"v"(b),"v"(c));return r;}
__device__ __forceinline__ float max2f(float a,float b){float r;asm("v_max_f32_e32 %0, %1, %2":"=v"(r):"v"(a),"v"(b));return r;}
__device__ __forceinline__ float fadd_s(float a,float b){float r;asm("v_add_f32_e32 %0, %1, %2":"=v"(r):"v"(a),"v"(b));return r;}
__device__ __forceinline__ float fsub_s(float a,float b){float r;asm("v_sub_f32_e32 %0, %1, %2":"=v"(r):"v"(a),"v"(b));return r;}
typedef float f32x2_t __attribute__((ext_vector_type(2))); typedef __bf16 bf16x2_t __attribute__((ext_vector_type(2)));
__device__ __forceinline__ unsigned cvtpk_s(float lo,float hi){f32x2_t v={lo,hi};bf16x2_t b=__builtin_convertvector(v,bf16x2_t);return __builtin_bit_cast(unsigned,b);}
#define WAIT_BAR(N) asm volatile("s_waitcnt vmcnt(" #N ") lgkmcnt(0)\n\ts_barrier":::"memory")

__device__ __forceinline__ void qkt(f32x16&p0,f32x16&p1,const char*Kslot,const bf16x8*qr,const f32x16&negm,int r32,int hi){
  const char*kb=Kslot+hi*1024+r32*16;
  #pragma unroll
  for(int d0=0;d0<4;++d0){
    const bf16x8 b0=*reinterpret_cast<const bf16x8*>(kb+d0*2048);
    const bf16x8 b1=*reinterpret_cast<const bf16x8*>(kb+d0*2048+512);
    if(d0==0){p0=__builtin_amdgcn_mfma_f32_32x32x16_bf16(b0,qr[0],negm,0,0,0);p1=__builtin_amdgcn_mfma_f32_32x32x16_bf16(b1,qr[0],negm,0,0,0);}
    else{p0=__builtin_amdgcn_mfma_f32_32x32x16_bf16(b0,qr[d0],p0,0,0,0);p1=__builtin_amdgcn_mfma_f32_32x32x16_bf16(b1,qr[d0],p1,0,0,0);}}
}
typedef __attribute__((address_space(3))) const char* lds_cptr;
typedef short v4i16_t __attribute__((ext_vector_type(4)));
__device__ __forceinline__ void kload8(bf16x8*kf,lds_cptr kp){
  kf[0]=*(const __attribute__((address_space(3))) bf16x8*)(kp);      kf[1]=*(const __attribute__((address_space(3))) bf16x8*)(kp+512);
  kf[2]=*(const __attribute__((address_space(3))) bf16x8*)(kp+2048); kf[3]=*(const __attribute__((address_space(3))) bf16x8*)(kp+2560);
  kf[4]=*(const __attribute__((address_space(3))) bf16x8*)(kp+4096); kf[5]=*(const __attribute__((address_space(3))) bf16x8*)(kp+4608);
  kf[6]=*(const __attribute__((address_space(3))) bf16x8*)(kp+6144); kf[7]=*(const __attribute__((address_space(3))) bf16x8*)(kp+6656);
}
__device__ __forceinline__ void kload2(bf16x8*kf,lds_cptr kp,int j){ kf[2*j]=*(const __attribute__((address_space(3))) bf16x8*)(kp+j*2048); kf[2*j+1]=*(const __attribute__((address_space(3))) bf16x8*)(kp+j*2048+512); }
__device__ __forceinline__ s16x4 vtr(lds_cptr p){ return __builtin_bit_cast(s16x4,__builtin_amdgcn_ds_read_tr16_b64_v4i16((__attribute__((address_space(3))) v4i16_t*)p)); }
__device__ __forceinline__ float rowmax(const f32x16&p0,const f32x16&p1){
  float a=max3f(p0[0],p0[1],p1[0]),b=max3f(p0[2],p0[3],p1[1]);a=max3f(a,p1[2],p1[3]);
  #pragma unroll
  for(int r=4;r<16;r+=4){a=max3f(a,p0[r],p0[r+1]);b=max3f(b,p0[r+2],p0[r+3]);a=max3f(a,p1[r],p1[r+1]);b=max3f(b,p1[r+2],p1[r+3]);}
  const float m=max2f(a,b);
  auto rr=__builtin_amdgcn_permlane32_swap(__float_as_uint(m),__float_as_uint(m),false,false);
  return max2f(__uint_as_float(rr[0]),__uint_as_float(rr[1]));
}
__device__ __forceinline__ void pv(f32x16*o,int vb,bf16x8 pa0,bf16x8 pa1,bf16x8 pa2,bf16x8 pa3){
  #pragma unroll
  for(int d0=0;d0<2;++d0){s16x4 lo[4],hi[4];
    #pragma unroll
    for(int ks=0;ks<4;++ks){
      asm volatile("ds_read_b64_tr_b16 %0,%1 offset:%c2":"=&v"(lo[ks]):"v"(vb),"i"(d0*4096+ks*1024):"memory");
      asm volatile("ds_read_b64_tr_b16 %0,%1 offset:%c2":"=&v"(hi[ks]):"v"(vb),"i"(d0*4096+ks*1024+512):"memory");}
    asm volatile("s_waitcnt lgkmcnt(0)":::"memory");SBAR();
    #define PK(k) (bf16x8){lo[k][0],lo[k][1],lo[k][2],lo[k][3],hi[k][0],hi[k][1],hi[k][2],hi[k][3]}
    o[d0]=__builtin_amdgcn_mfma_f32_32x32x16_bf16(pa0,PK(0),o[d0],0,0,0);
    o[d0]=__builtin_amdgcn_mfma_f32_32x32x16_bf16(pa1,PK(1),o[d0],0,0,0);
    o[d0]=__builtin_amdgcn_mfma_f32_32x32x16_bf16(pa2,PK(2),o[d0],0,0,0);
    o[d0]=__builtin_amdgcn_mfma_f32_32x32x16_bf16(pa3,PK(3),o[d0],0,0,0);
    #undef PK
  }
}

#ifndef ATTN_STORE16
#define ATTN_STORE16(p,v) (*(u32x4*)(p)=(v))
#endif
template<int THRL> __device__ __forceinline__ void attn_unit(int qb,const bf16*Qp,const bf16*__restrict__ Kh,const bf16*__restrict__ Vh,bf16*Op,char*shm,const float mfix){
  const int tid=threadIdx.x,lane=tid&63,r32=lane&31,hi=lane>>5; const int wid=__builtin_amdgcn_readfirstlane(tid>>6);
  const int q0=qb*QB;
  const bf16*Qw=Qp+(long)(q0+wid*QBLK)*DM;
  const unsigned lds0=(unsigned)(uintptr_t)shm;
  float*wsf=(float*)(shm+LDS_WS)+wid*64;
  const bf16*ksrc=Kh+(long)lane*DM+wid*8;
  const bf16*vsrc=Vh+(long)(16*(wid&3)+(lane>>2))*DM+(wid>>2)*32+(lane&3)*8;
  const unsigned kdst=lds0+LDS_K+wid*1024, vdst=lds0+LDS_V+wid*1024;
  #define DMA_K(t,slot) glds16(ksrc+(long)(t)*KVBLK*DM,(unsigned)__builtin_amdgcn_readfirstlane(kdst+(slot)))
  #define DMA_V(t,slot) glds16(vsrc+(long)(t)*KVBLK*DM,(unsigned)__builtin_amdgcn_readfirstlane(vdst+(slot)))
  const int vb0=(int)(lds0+LDS_V)+((lane>>4)&1)*32+(lane&3)*8+(4*hi+((lane&15)>>2))*64;
  const char*Kbase=shm+LDS_K; bf16x8 kf[8];
  const lds_cptr shm3=(lds_cptr)shm; const lds_cptr kp0=shm3+LDS_K+hi*1024+r32*16; const lds_cptr vp0=shm3+LDS_V+((lane>>4)&1)*32+(lane&3)*8+(4*hi+((lane&15)>>2))*64;
  constexpr int NT=SEQ/KVBLK;
  DMA_K(0,0);DMA_V(0,0);DMA_K(1,SLOTB);
  bf16x8 qr[4];
  #pragma unroll
  for(int d0=0;d0<4;++d0)qr[d0]=*reinterpret_cast<const bf16x8*>(&Qw[(long)r32*DM+d0*16+hi*8]);
  float l_reg=0.f;f32x16 o[2];o[0]=f32x16{};o[1]=f32x16{};f32x16 negm;
  _Pragma("unroll") for(int r=0;r<16;++r)negm[r]=-mfix; asm volatile("":"+v"(negm));
  const int qrel=wid*QBLK+r32;
  #define CMASK(P0,P1,t) do{}while(0)
  #define START(P0,P1) do{ _Pragma("unroll") for(int r=0;r<16;++r)P0[r]=__builtin_amdgcn_exp2f(P0[r]); }while(0)
  #define RESC() do{}while(0)
  f32x16 pA0,pA1,pB0,pB1;
  int sl_prev=0,sl_cur=0,sl_next=SLOTB;
  #define ROT() do{sl_prev=sl_cur;sl_cur=sl_next;sl_next=(sl_next==(NSLOT-1)*SLOTB)?0:sl_next+SLOTB;}while(0)
  DMA_K(2,2*SLOTB);
  WAIT_BAR(3);
  qkt(pA0,pA1,Kbase,qr,negm,r32,hi);asm volatile("s_nop 15\n\ts_nop 7":"+v"(pA0),"+v"(pA1));CMASK(pA0,pA1,0);
  START(pA0,pA1);
  _Pragma("unroll") for(int r=0;r<16;++r)pA1[r]=__builtin_amdgcn_exp2f(pA1[r]);
  WAIT_BAR(0);
  DMA_K(3,0);DMA_V(1,SLOTB);
  ROT();
  kload8(kf,kp0+sl_cur);
  WAIT_BAR(2);
  s16x4 vlo[8],vhi[8]; u32x4 pw0,pw1,pw2,pw3;
  #define PKW(P,B) cvtpk_s(P[B],P[B+1])
  #define PAF(k) __builtin_bit_cast(bf16x8,pw##k)
  #define VFR(i) (bf16x8){vlo[i][0],vlo[i][1],vlo[i][2],vlo[i][3],vhi[i][0],vhi[i][1],vhi[i][2],vhi[i][3]}
  #define PIN(x) asm volatile("":"+v"(x))
  #define MX3(a,b,c) __builtin_fmaxf(__builtin_fmaxf((a),(b)),(c))
  #define GAPA(MF,A0,A1,A2,A3,W0,W1,PW) do{ MF; sacc+=A0; sacc+=A1; sacc+=A2; sacc+=A3; PIN(sacc); W0; W1; PIN(PW); SBAR(); }while(0)
  #define EX(v) __builtin_amdgcn_exp2f(v)
  #define GAPB(MF,X,B) do{ MF; X[B]=EX(X[B]); X[B+1]=EX(X[B+1]); X[B+2]=EX(X[B+2]); X[B+3]=EX(X[B+3]); PIN(X); SBAR(); }while(0)
  #define VRD(i) do{ vlo[i]=vtr(vp_+(((i)>>2)*4096+((i)&3)*1024)); vhi[i]=vtr(vp_+(((i)>>2)*4096+((i)&3)*1024+512)); }while(0)
  #define KRD(G,j) do{ if(G){ kload2(kf,kp0+sl_next,j); SBAR(); } }while(0)
  #define STEP(C0,C1,P0,P1,t,GK,GV,GL) do{ SBAR(); \
    const lds_cptr vp_=vp0+sl_prev; \
    VRD(0); SBAR(); float sacc=(P0[0]+P0[1]); \
    GAPA(C0=__builtin_amdgcn_mfma_f32_32x32x16_bf16(kf[0],qr[0],negm,0,0,0), P0[2],P0[3],P0[4],P0[5],     pw0[0]=PKW(P0,0), pw0[1]=PKW(P0,2), pw0); \
    VRD(4); SBAR(); GAPA(C1=__builtin_amdgcn_mfma_f32_32x32x16_bf16(kf[1],qr[0],negm,0,0,0), P0[6],P0[7],P0[8],P0[9],     pw0[2]=PKW(P0,4), pw0[3]=PKW(P0,6), pw0); \
    VRD(1); SBAR(); GAPA(C0=__builtin_amdgcn_mfma_f32_32x32x16_bf16(kf[2],qr[1],C0,0,0,0),   P0[10],P0[11],P0[12],P0[13], pw1[0]=PKW(P0,8), pw1[1]=PKW(P0,10), pw1); \
    VRD(5); SBAR(); GAPA(C1=__builtin_amdgcn_mfma_f32_32x32x16_bf16(kf[3],qr[1],C1,0,0,0),   P0[14],P0[15],P1[0],P1[1],   pw1[2]=PKW(P0,12),pw1[3]=PKW(P0,14), pw1); \
    VRD(2); SBAR(); GAPA(C0=__builtin_amdgcn_mfma_f32_32x32x16_bf16(kf[4],qr[2],C0,0,0,0),   P1[2],P1[3],P1[4],P1[5],     pw2[0]=PKW(P1,0), pw2[1]=PKW(P1,2), pw2); \
    VRD(6); SBAR(); GAPA(C1=__builtin_amdgcn_mfma_f32_32x32x16_bf16(kf[5],qr[2],C1,0,0,0),   P1[6],P1[7],P1[8],P1[9],     pw2[2]=PKW(P1,4), pw2[3]=PKW(P1,6), pw2); \
    VRD(3); SBAR(); GAPA(C0=__builtin_amdgcn_mfma_f32_32x32x16_bf16(kf[6],qr[3],C0,0,0,0),   P1[10],P1[11],P1[12],P1[13], pw3[0]=PKW(P1,8), pw3[1]=PKW(P1,10), pw3); \
    VRD(7); SBAR(); GAPA(C1=__builtin_amdgcn_mfma_f32_32x32x16_bf16(kf[7],qr[3],C1,0,0,0),   P1[14],P1[15],0.f,0.f,       pw3[2]=PKW(P1,12),pw3[3]=PKW(P1,14), pw3); \
    l_reg+=sacc; \
    if(GK){DMA_K((t)+3,sl_cur);} if(GV){DMA_V((t)+1,sl_next);} \
    CMASK(C0,C1,t); \
    SBAR(); \
    GAPB(o[0]=__builtin_amdgcn_mfma_f32_32x32x16_bf16(PAF(0),VFR(0),o[0],0,0,0), C0,0); \
    GAPB(o[1]=__builtin_amdgcn_mfma_f32_32x32x16_bf16(PAF(0),VFR(4),o[1],0,0,0), C0,4); \
    KRD(GL,0); GAPB(o[0]=__builtin_amdgcn_mfma_f32_32x32x16_bf16(PAF(1),VFR(1),o[0],0,0,0), C0,8); \
    KRD(GL,1); GAPB(o[1]=__builtin_amdgcn_mfma_f32_32x32x16_bf16(PAF(1),VFR(5),o[1],0,0,0), C0,12); \
    KRD(GL,2); GAPB(o[0]=__builtin_amdgcn_mfma_f32_32x32x16_bf16(PAF(2),VFR(2),o[0],0,0,0), C1,0); \
    KRD(GL,3); GAPB(o[1]=__builtin_amdgcn_mfma_f32_32x32x16_bf16(PAF(2),VFR(6),o[1],0,0,0), C1,4); \
    GAPB(o[0]=__builtin_amdgcn_mfma_f32_32x32x16_bf16(PAF(3),VFR(3),o[0],0,0,0), C1,8); \
    GAPB(o[1]=__builtin_amdgcn_mfma_f32_32x32x16_bf16(PAF(3),VFR(7),o[1],0,0,0), C1,12); \
    }while(0)
  int t=1;
  #undef CMASK
  #define CMASK(P0,P1,t) do{}while(0)
  for(;t+5<NT;t+=2){
    STEP(pB0,pB1,pA0,pA1,t,true,true,true);     WAIT_BAR(2); RESC(); ROT();
    STEP(pA0,pA1,pB0,pB1,t+1,true,true,true);   WAIT_BAR(2); RESC(); ROT();
  }
  #undef CMASK
  #define CMASK(P0,P1,t) do{}while(0)
  #define ENDW(tt) do{ if((tt)+3<NT){WAIT_BAR(2);} else if((tt)+2<NT){WAIT_BAR(1);} else {WAIT_BAR(0);} }while(0)
  for(;t+1<NT;t+=2){
    STEP(pB0,pB1,pA0,pA1,t,(t+3<NT),(t+1<NT),(t+1<NT));       ENDW(t);   RESC(); ROT();
    STEP(pA0,pA1,pB0,pB1,t+1,(t+4<NT),(t+2<NT),(t+2<NT));     ENDW(t+1); RESC(); ROT();
  }
  STEP(pB0,pB1,pA0,pA1,NT-1,false,false,false); RESC();
  { float sacc=pB0[0]+pB0[1]; _Pragma("unroll") for(int r=2;r<16;++r)sacc+=pB0[r]; _Pragma("unroll") for(int r=0;r<16;++r)sacc+=pB1[r]; l_reg+=sacc;
    pw0=(u32x4){PKW(pB0,0),PKW(pB0,2),PKW(pB0,4),PKW(pB0,6)};pw1=(u32x4){PKW(pB0,8),PKW(pB0,10),PKW(pB0,12),PKW(pB0,14)};pw2=(u32x4){PKW(pB1,0),PKW(pB1,2),PKW(pB1,4),PKW(pB1,6)};pw3=(u32x4){PKW(pB1,8),PKW(pB1,10),PKW(pB1,12),PKW(pB1,14)};
    SBAR(); pv(o,vb0+sl_cur,PAF(0),PAF(1),PAF(2),PAF(3)); }
  #undef PKW
  #undef PAF
  #undef VFR
  #undef PIN
  #undef MX3
  #undef GAPA
  #undef GAPB
  #undef EX
  #undef VRD
  #undef KRD
  #undef STEP
  #undef ENDW
  {auto rr=__builtin_amdgcn_permlane32_swap(__float_as_uint(l_reg),__float_as_uint(l_reg),false,false);l_reg=__uint_as_float(rr[0])+__uint_as_float(rr[1]);}
  if(hi==0)wsf[32+r32]=l_reg;asm volatile("s_waitcnt lgkmcnt(0)":::"memory");
  float rli[16];
  #pragma unroll
  for(int r=0;r<16;++r)rli[r]=__builtin_amdgcn_rcpf(wsf[32+crow(r,hi)]);
  bf16*Ow=Op+(long)(q0+wid*QBLK)*OPITCH;
  { bf16*stg=(bf16*)(shm+LDS_OST)+wid*2048;
    #pragma unroll
    for(int r=0;r<16;++r){const int orow=crow(r,hi);
      #pragma unroll
      for(int d0=0;d0<2;++d0)stg[orow*64+d0*32+r32]=__float2bfloat16(o[d0][r]*rli[r]);}
    asm volatile("s_waitcnt lgkmcnt(0)":::"memory");
    #pragma unroll
    for(int i=0;i<4;++i){const int row=i*8+(lane>>3),ch=lane&7; const u32x4 v=*(const u32x4*)(stg+row*64+ch*8); ATTN_STORE16(Ow+(long)row*OPITCH+ch*8,v);} }
  asm volatile("s_waitcnt lgkmcnt(0)\n\ts_barrier":::"memory");
  #undef DMA_K
  #undef DMA_V
  #undef CMASK
  #undef START
  #undef RESC
  #undef ROT
}
constexpr int ATTN_LDS_BYTES=LDS_BYTES;
#undef SBAR
#undef WAIT_BAR
}
#include <hip/hip_cooperative_groups.h>
namespace cg = cooperative_groups;
#ifndef REP_ATT
#define REP_ATT 1
#endif
#ifndef REP_G3
#define REP_G3 1
#endif
#ifndef REP_G1
#define REP_G1 1
#endif
#ifndef REP_P7
#define REP_P7 1
#endif
#ifndef P7_PIPE
#define P7_PIPE 1
#endif
#ifndef MK_CMP7
#define MK_CMP7 0
#endif
#ifndef MK_DIAG
#define MK_DIAG 0
#endif
#ifndef MK_PER_PHASE
#define MK_PER_PHASE 0
#endif
constexpr int NWAVES = 8, NTHR = 512;
constexpr int SEQL = 16384, NSEQ = 3, TOK = NSEQ * SEQL, DMODEL = 1024, NPROJ = 2560, DFF = 2816, NUP = 5632, INW = 2336;
constexpr int NCHUNK = SEQL / 64, NITEM = NSEQ * 4 * NCHUNK;
constexpr float RMS_EPS = 1e-6f;
constexpr int C_GQ = 0, C_GK = 256, C_GV = 512, C_GG = 1024, C_AQ = 1536, C_AK = 2048, C_AV = 2176, C_RF = 2304;
constexpr size_t MiB = 1u << 20;
constexpr size_t WS_WIN = 0, WS_WOUT = 5 * MiB, WS_WUP = 7 * MiB, WS_WDN = 18 * MiB, WS_ROPE = 24 * MiB, WS_DEC = 24 * MiB + 65536;
constexpr size_t WS_H = 26 * MiB;
constexpr size_t WS_A = 124 * MiB;
constexpr size_t WS_S = 364 * MiB;
constexpr size_t WS_H2 = 388 * MiB;
constexpr size_t WS_SSQ2 = 23 * MiB + 512 * 1024;
constexpr size_t WS_SSQ = 25 * MiB + 640 * 1024;
constexpr size_t WS_END = 485 * MiB;
constexpr int LDS_BYTES = 147456;
typedef unsigned short bf16_t;
typedef float f32x4 __attribute__((ext_vector_type(4)));
typedef float f32x16 __attribute__((ext_vector_type(16)));
typedef short bf16x8 __attribute__((ext_vector_type(8)));
typedef unsigned u32x4 __attribute__((ext_vector_type(4)));
typedef unsigned u32x2 __attribute__((ext_vector_type(2)));
#define LAS __attribute__((address_space(3)))
#define DI __device__ __forceinline__

DI unsigned pk2(float lo, float hi) { return pg8::cvt_pk_bf16(lo, hi); }
DI float bflo(unsigned w) { return __uint_as_float(w << 16); }
DI float bfhi(unsigned w) { return __uint_as_float(w & 0xffff0000u); }
DI unsigned short f2bf(float f) { return (unsigned short)(pk2(f, 0.f) & 0xffffu); }
DI float wave_sum(float v) {
#pragma unroll
    for (int o = 1; o < 64; o <<= 1) v += __shfl_xor(v, o);
    return v;
}
DI int crow16(int r, int hi) { return (r & 3) + 8 * (r >> 2) + 4 * hi; }

#define XB_TMO      128
#define XB_XCNT(j)  (256  + 64 * (j))
#define XB_XSUB(j)  (1280 + 64 * (j))
#define XB_XGEN(j)  (2304 + 64 * (j))
#define XB_TOP      3328
#define XB_TOPGEN   3392
#define XCD_BAR_WORDS 3456
#define XB_SPIN_CAP (1u << 18)

__device__ __forceinline__ unsigned xb_ld(unsigned* p)              { return __hip_atomic_load(p, __ATOMIC_RELAXED, __HIP_MEMORY_SCOPE_AGENT); }
__device__ __forceinline__ unsigned xb_add(unsigned* p, unsigned v) { return __hip_atomic_fetch_add(p, v, __ATOMIC_RELAXED, __HIP_MEMORY_SCOPE_AGENT); }
__device__ __forceinline__ unsigned xb_xcc_id() { return (unsigned)__builtin_amdgcn_s_getreg((3 << 11) | 20) & 0xFu; }
#define XB_SPIN(cond, bar) do { unsigned _sp = 0; while (cond) { __builtin_amdgcn_s_sleep(1); \
    if ((++_sp & 255u) == 0u) { if (xb_ld(&(bar)[XB_TMO])) break; if (_sp > XB_SPIN_CAP) { atomicAdd(&(bar)[XB_TMO], 1u); break; } } } } while (0)

struct XcdBarrier {
    unsigned* bar; unsigned x;
    volatile LAS unsigned* st;
};

__device__ __forceinline__ XcdBarrier xcd_barrier_post(unsigned* bar, volatile LAS unsigned* st) {
    XcdBarrier b; b.bar = bar; b.x = xb_xcc_id(); b.st = st;
    if (threadIdx.x == 0) (void)xb_add(&bar[XB_XCNT(b.x)], 1u);
    return b;
}
__device__ __forceinline__ void xcd_barrier_complete(unsigned* bar, unsigned x, unsigned& nloc, unsigned& nx) {
    const unsigned G = gridDim.x * gridDim.y * gridDim.z;
    unsigned sum, cnt, mine, sp = 0u;
    for (;;) {
        sum = 0u; cnt = 0u; mine = 0u;
#pragma unroll
        for (unsigned j = 0; j < 16; ++j) { const unsigned c = xb_ld(&bar[XB_XCNT(j)]); sum += c; cnt += (c > 0u) ? 1u : 0u; mine = (j == x) ? c : mine; }
        if (sum == G) break;
        __builtin_amdgcn_s_sleep(1);
        if ((++sp & 255u) == 0u) { if (xb_ld(&bar[XB_TMO])) break; if (sp > XB_SPIN_CAP) { atomicAdd(&bar[XB_TMO], 1u); break; } }
    }
    nloc = mine > 0u ? mine : 1u; nx = cnt > 0u ? cnt : 1u;
}

__device__ __forceinline__ void xcd_barrier(const XcdBarrier& b) {
    asm volatile("s_waitcnt vmcnt(0)" ::: "memory");
    __syncthreads();
    if (threadIdx.x == 0) {
        unsigned* bar = b.bar;
        __builtin_amdgcn_s_waitcnt(0);
        unsigned nloc = b.st[0], nx = b.st[1];
        if (nloc == 0u) { xcd_barrier_complete(bar, b.x, nloc, nx); b.st[0] = nloc; b.st[1] = nx; }
        const unsigned old = xb_add(&bar[XB_XSUB(b.x)], 1u);
        const unsigned gen = old / nloc;
        if (old + 1u == (gen + 1u) * nloc) {
            __builtin_amdgcn_fence(__ATOMIC_RELEASE, "agent");
            asm volatile("s_waitcnt vmcnt(0)" ::: "memory");
            const unsigned og = xb_add(&bar[XB_TOP], 1u);
            const unsigned tg = og / nx;
            if (og + 1u == (tg + 1u) * nx) xb_add(&bar[XB_TOPGEN], 1u);
            else XB_SPIN(xb_ld(&bar[XB_TOPGEN]) == tg, bar);
            __builtin_amdgcn_fence(__ATOMIC_ACQUIRE, "agent");
            xb_add(&bar[XB_XGEN(b.x)], 1u);
            asm volatile("s_waitcnt vmcnt(0)" ::: "memory");
        } else {
            XB_SPIN(xb_ld(&bar[XB_XGEN(b.x)]) == gen, bar);
            __builtin_amdgcn_fence(__ATOMIC_ACQUIRE, "agent");
            asm volatile("s_waitcnt vmcnt(0)" ::: "memory");
        }
    }
    __syncthreads();
}

struct Args { const float* in[18]; float* out; unsigned char* ws; int ph_lo, ph_hi, chk, pad; };
constexpr size_t WS_FLAG = 25 * MiB + 896 * 1024;
constexpr size_t WS_BAR = 25 * MiB + 928 * 1024;
constexpr int LDS_BARST = LDS_BYTES - 64;

DI void p0_transpose_item(const float* W, int K, int N, bf16_t* WT, LAS float* scr, int item, int lane, int mode) {
    const int nblk = N / 32, kb = item / nblk, nb = item % nblk, k0 = 64 * kb, n0 = 32 * nb;
    int r0 = n0;
    if (mode == 1) r0 = n0 < 1536 ? n0 : (n0 == 1536 ? C_RF : n0 - 32);
    else if (mode == 2) r0 = n0 < DFF ? (n0 / 128) * 256 + (n0 % 128) : ((n0 - DFF) / 128) * 256 + 128 + ((n0 - DFF) % 128);
#pragma unroll 8
    for (int i = 0; i < 32; ++i) { const int kk = 2 * i + (lane >> 5); scr[kk * 33 + (lane & 31)] = W[(size_t)(k0 + kk) * N + n0 + (lane & 31)]; }
    asm volatile("s_waitcnt lgkmcnt(0)" ::: "memory");
    const int c = lane & 7;
#pragma unroll
    for (int j = 0; j < 4; ++j) { const int n = (lane >> 3) + 8 * j; const LAS float* s = scr + (8 * c) * 33 + n;
        u32x4 o; o.x = pk2(s[0 * 33], s[1 * 33]); o.y = pk2(s[2 * 33], s[3 * 33]); o.z = pk2(s[4 * 33], s[5 * 33]); o.w = pk2(s[6 * 33], s[7 * 33]);
        *(u32x4*)(WT + (size_t)(r0 + n) * K + k0 + 8 * c) = o; }
    asm volatile("s_waitcnt lgkmcnt(0)" ::: "memory");
}
DI void rms_row_to_bf16(const float* xrow, const float* w, bf16_t* orow, int lane) {
    const f32x4* xr = (const f32x4*)xrow + lane; const f32x4* wr = (const f32x4*)w + lane;
    f32x4 v[4]; float s = 0.f;
#pragma unroll
    for (int j = 0; j < 4; ++j) { v[j] = xr[64 * j]; s += (v[j].x * v[j].x + v[j].y * v[j].y) + (v[j].z * v[j].z + v[j].w * v[j].w); }
    const float rstd = 1.0f / sqrtf(wave_sum(s) * (1.f / 1024.f) + RMS_EPS);
    u32x2* o8 = (u32x2*)orow + lane;
#pragma unroll
    for (int j = 0; j < 4; ++j) { const f32x4 g = wr[64 * j]; u32x2 o; o.x = pk2(v[j].x * rstd * g.x, v[j].y * rstd * g.y); o.y = pk2(v[j].z * rstd * g.z, v[j].w * rstd * g.w); o8[64 * j] = o; }
}
DI void rms_row_inplace(float* xrow, const float* w, int lane) {
    f32x4* xr = (f32x4*)xrow + lane; const f32x4* wr = (const f32x4*)w + lane;
    f32x4 v[4]; float s = 0.f;
#pragma unroll
    for (int j = 0; j < 4; ++j) { v[j] = xr[64 * j]; s += (v[j].x * v[j].x + v[j].y * v[j].y) + (v[j].z * v[j].z + v[j].w * v[j].w); }
    const float rstd = 1.0f / sqrtf(wave_sum(s) * (1.f / 1024.f) + RMS_EPS);
#pragma unroll
    for (int j = 0; j < 4; ++j) { const f32x4 g = wr[64 * j]; f32x4 o = v[j] * rstd * g;
#pragma unroll
        for (int e = 0; e < 4; ++e) if (!(fabsf(o[e]) < 1e30f)) o[e] = 12345.0f;
        xr[64 * j] = o; }
}

DI void rms_row_final(const bf16_t* xrow, float q, const float* w, float* orow, int lane) {
    const float rstd = 1.0f / sqrtf(q * (1.f / 1024.f) + RMS_EPS);
    const u32x4 a = ((const u32x4*)xrow)[lane], b = ((const u32x4*)xrow)[64 + lane];
    const f32x4 g0 = ((const f32x4*)w)[2 * lane], g1 = ((const f32x4*)w)[2 * lane + 1], g2 = ((const f32x4*)w)[128 + 2 * lane], g3 = ((const f32x4*)w)[128 + 2 * lane + 1];
    f32x4* o = (f32x4*)orow;
    o[2 * lane] = (f32x4){bflo(a.x), bfhi(a.x), bflo(a.y), bfhi(a.y)} * rstd * g0; o[2 * lane + 1] = (f32x4){bflo(a.z), bfhi(a.z), bflo(a.w), bfhi(a.w)} * rstd * g1;
    o[128 + 2 * lane] = (f32x4){bflo(b.x), bfhi(b.x), bflo(b.y), bfhi(b.y)} * rstd * g2; o[128 + 2 * lane + 1] = (f32x4){bflo(b.z), bfhi(b.z), bflo(b.w), bfhi(b.w)} * rstd * g3;
}

constexpr int G_RF = 0, G_WG = 8192, G_BIAS = 16384, G_BF = 16896, G_BB = 33280, G_Q0 = 50688, G_VT = 87552, G_AF = 105984, G_AB = 115200, G_END = 124416;
constexpr int GP = 72;
struct GlaIn { const bf16_t* proj; const float *wgf, *bgf, *wgb, *bgb; };
DI float logsig16(float x) { return (fminf(x, 0.f) - __logf(1.0f + __expf(-fabsf(x)))) * 0.0625f; }
DI void lds_barrier() { asm volatile("s_waitcnt lgkmcnt(0)" ::: "memory"); __builtin_amdgcn_s_barrier(); asm volatile("" ::: "memory"); }
struct GlaPre { bf16x8 a; float w[8]; float bi; };
struct G1Loads { GlaPre pre; u32x4 kv, vv0, vv1; };
struct G3Loads { GlaPre pre; u32x4 qv, kv, vv0, vv1, g0, g1; bf16x8 s0[4], s1[4]; };
DI void gla_issue_pre(GlaPre& P, const GlaIn& gi, int tok0, int h, int tid) {
    const int lane = tid & 63, w = tid >> 6, dir = w >> 2, mt = (w >> 1) & 1, nd = w & 1, r32 = lane & 31, hi = lane >> 5;
    P.a = *(const bf16x8*)(gi.proj + (size_t)(tok0 + mt * 32 + r32) * NPROJ + C_RF + dir * 16 + hi * 8);
    const float* wsrc = (dir ? gi.wgb : gi.wgf) + (8 * hi) * 256 + h * 64 + nd * 32 + r32;
#pragma unroll
    for (int j = 0; j < 8; ++j) P.w[j] = wsrc[j * 256];
    P.bi = (dir ? gi.bgb : gi.bgf)[h * 64 + nd * 32 + r32];
}
DI void g1_issue(G1Loads& L, const GlaIn& gi, int item, int tid) {
    const int c = item & 255, h = (item >> 8) & 3, b = item >> 10, tok0 = b * SEQL + c * 64;
    gla_issue_pre(L.pre, gi, tok0, h, tid);
    const bf16_t* prow = gi.proj + (size_t)(tok0 + (tid >> 3)) * NPROJ;
    L.kv = *(const u32x4*)(prow + C_GK + h * 64 + (tid & 7) * 8);
    L.vv0 = *(const u32x4*)(prow + C_GV + h * 128 + (tid & 7) * 16); L.vv1 = *(const u32x4*)(prow + C_GV + h * 128 + (tid & 7) * 16 + 8);
}
DI void g3_issue(G3Loads& L, const GlaIn& gi, const bf16_t* sbuf, int item, int tid) {
    const int c = item & 255, h = (item >> 8) & 3, b = item >> 10, tok0 = b * SEQL + c * 64;
    gla_issue_pre(L.pre, gi, tok0, h, tid);
    const bf16_t* prow = gi.proj + (size_t)(tok0 + (tid >> 3)) * NPROJ;
    L.qv = *(const u32x4*)(prow + C_GQ + h * 64 + (tid & 7) * 8); L.kv = *(const u32x4*)(prow + C_GK + h * 64 + (tid & 7) * 8);
    L.vv0 = *(const u32x4*)(prow + C_GV + h * 128 + (tid & 7) * 16); L.vv1 = *(const u32x4*)(prow + C_GV + h * 128 + (tid & 7) * 16 + 8);
    L.g0 = *(const u32x4*)(prow + C_GG + h * 128 + (tid & 7) * 16); L.g1 = *(const u32x4*)(prow + C_GG + h * 128 + (tid & 7) * 16 + 8);
    const int lane = tid & 63, w = tid >> 6, nv = w & 3, r32 = lane & 31, hi = lane >> 5;
    const bf16_t* s0 = sbuf + (size_t)item * 8192 + (nv * 32 + r32) * 64 + hi * 8; const bf16_t* s1 = s0 + (size_t)NITEM * 8192;
#pragma unroll
    for (int ks = 0; ks < 4; ++ks) { L.s0[ks] = *(const bf16x8*)(s0 + ks * 16); L.s1[ks] = *(const bf16x8*)(s1 + ks * 16); }
}
DI void gla_preamble(LAS unsigned char* lds, const GlaPre& P, int tid) {
    LAS float* RF = (LAS float*)(lds + G_RF);
    LAS float* BF = (LAS float*)(lds + G_BF); LAS float* BB = (LAS float*)(lds + G_BB);
    {
        const int lane = tid & 63, w = tid >> 6, dir = w >> 2, mt = (w >> 1) & 1, nd = w & 1, r32 = lane & 31, hi = lane >> 5;
        const u32x4 bw = {pk2(P.w[0], P.w[1]), pk2(P.w[2], P.w[3]), pk2(P.w[4], P.w[5]), pk2(P.w[6], P.w[7])};
        f32x16 acc = {}; acc = __builtin_amdgcn_mfma_f32_32x32x16_bf16(P.a, __builtin_bit_cast(bf16x8, bw), acc, 0, 0, 0);
        LAS float* dst = (dir ? BB : BF) + (mt * 32) * 64 + nd * 32 + r32;
#pragma unroll
        for (int r = 0; r < 16; ++r) dst[crow16(r, hi) * 64] = logsig16(acc[r] + P.bi); }
    lds_barrier();
    {
        const int d = tid & 63, seg = (tid >> 6) & 3, dir = tid >> 8; LAS float* SEGT = RF;
        LAS float* Bd = (dir ? BB : BF) + d; float v[16];
#pragma unroll
        for (int i = 0; i < 16; ++i) v[i] = Bd[(dir ? (seg * 16 + 15 - i) : (seg * 16 + i)) * 64];
#pragma unroll
        for (int i = 1; i < 16; ++i) v[i] += v[i - 1];
        SEGT[(dir * 4 + seg) * 64 + d] = v[15];
        lds_barrier();
        float off = 0.f;
#pragma unroll
        for (int s2 = 0; s2 < 4; ++s2) { const float tt = SEGT[(dir * 4 + s2) * 64 + d]; if (dir ? (s2 > seg) : (s2 < seg)) off += tt; }
#pragma unroll
        for (int i = 0; i < 16; ++i) Bd[(dir ? (seg * 16 + 15 - i) : (seg * 16 + i)) * 64] = v[i] + off;
    }
    lds_barrier();
}
DI void gla_store_vt(LAS unsigned char* lds, const u32x4 v0, const u32x4 v1, int tid) {
    LAS bf16_t* VT = (LAS bf16_t*)(lds + G_VT); const int t = tid >> 3, j = tid & 7;
    LAS bf16_t* d = VT + (j * 16) * GP + t;
    d[0 * GP] = (bf16_t)(v0.x & 0xffffu); d[1 * GP] = (bf16_t)(v0.x >> 16); d[2 * GP] = (bf16_t)(v0.y & 0xffffu); d[3 * GP] = (bf16_t)(v0.y >> 16);
    d[4 * GP] = (bf16_t)(v0.z & 0xffffu); d[5 * GP] = (bf16_t)(v0.z >> 16); d[6 * GP] = (bf16_t)(v0.w & 0xffffu); d[7 * GP] = (bf16_t)(v0.w >> 16);
    d[8 * GP] = (bf16_t)(v1.x & 0xffffu); d[9 * GP] = (bf16_t)(v1.x >> 16); d[10 * GP] = (bf16_t)(v1.y & 0xffffu); d[11 * GP] = (bf16_t)(v1.y >> 16);
    d[12 * GP] = (bf16_t)(v1.z & 0xffffu); d[13 * GP] = (bf16_t)(v1.z >> 16); d[14 * GP] = (bf16_t)(v1.w & 0xffffu); d[15 * GP] = (bf16_t)(v1.w >> 16);
}
DI void gla_g1_item(LAS unsigned char* lds, const G1Loads& L, bf16_t* sbuf, float* dec, int item, int tid, unsigned* fl) {
    const int lane = tid & 63, w = tid >> 6, r32 = lane & 31, hi = lane >> 5;
    const u32x4 kv = L.kv, vv0 = L.vv0, vv1 = L.vv1;
    gla_preamble(lds, L.pre, tid);
    LAS float* BF = (LAS float*)(lds + G_BF); LAS float* BB = (LAS float*)(lds + G_BB);
    LAS bf16_t* KEF = (LAS bf16_t*)(lds + G_Q0); LAS bf16_t* KEB = KEF + 64 * GP; LAS bf16_t* VT = (LAS bf16_t*)(lds + G_VT);
#if MK_DIAG
    { const LAS float* RFd = (const LAS float*)(lds + G_RF); bool b12 = false, b13 = false; for (int i = tid; i < 2048; i += 512) b12 |= !(fabsf(RFd[i]) < 1e30f);
      for (int i = tid; i < 4096; i += 512) b13 |= !(fabsf(BF[i]) < 1e30f) | !(fabsf(BB[i]) < 1e30f) | (BF[i] > 0.f) | (BB[i] > 0.f);
      if (b12) atomicOr(fl + 12, 1u); if (b13) atomicOr(fl + 13, 1u); }
#endif
    { const int t = tid >> 3, d0 = (tid & 7) * 8;
        const float kf[8] = {bflo(kv.x), bfhi(kv.x), bflo(kv.y), bfhi(kv.y), bflo(kv.z), bfhi(kv.z), bflo(kv.w), bfhi(kv.w)};
#pragma unroll
        for (int i = 0; i < 8; ++i) { const int d = d0 + i; const float ef = __expf(BF[63 * 64 + d] - BF[t * 64 + d]), eb = __expf(BB[d] - BB[t * 64 + d]);
            KEF[d * GP + t] = f2bf(kf[i] * ef); KEB[d * GP + t] = f2bf(kf[i] * eb); } }
    gla_store_vt(lds, vv0, vv1, tid);
    if (tid < 64) dec[(size_t)item * 64 + tid] = __expf(BF[63 * 64 + tid]);
    else if (tid < 128) dec[(size_t)(NITEM + item) * 64 + (tid - 64)] = __expf(BB[tid - 64]);
    lds_barrier();
#if MK_DIAG
    { bool b14 = false; for (int i = tid; i < 64 * GP; i += 512) { if ((i % GP) < 64) b14 |= ((KEF[i] & 0x7F80) == 0x7F80) | ((KEB[i] & 0x7F80) == 0x7F80); }
      for (int i = tid; i < 128 * GP; i += 512) { if ((i % GP) < 64) b14 |= ((VT[i] & 0x7F80) == 0x7F80); } if (b14) atomicOr(fl + 14, 1u); }
#endif
    { const int mv = w >> 1, nk = w & 1;
#pragma unroll
        for (int dir = 0; dir < 2; ++dir) { const LAS bf16_t* KE = dir ? KEB : KEF; f32x16 acc = {};
#pragma unroll
            for (int ks = 0; ks < 4; ++ks) { const bf16x8 A = *(const LAS bf16x8*)(VT + (mv * 32 + r32) * GP + ks * 16 + hi * 8), B = *(const LAS bf16x8*)(KE + (nk * 32 + r32) * GP + ks * 16 + hi * 8);
                acc = __builtin_amdgcn_mfma_f32_32x32x16_bf16(A, B, acc, 0, 0, 0); }
            bf16_t* dst = sbuf + (size_t)(dir * NITEM + item) * 8192;
#pragma unroll
            for (int r = 0; r < 16; ++r) { dst[(mv * 32 + crow16(r, hi)) * 64 + nk * 32 + r32] = f2bf(acc[r]);
#if MK_DIAG
                if (!(fabsf(acc[r]) < 1e30f)) atomicOr(fl + 15, 1u);
#endif
            } } }
    lds_barrier();
}
DI void gla_g3_item(LAS unsigned char* lds, const G3Loads& L, const float* onorm, bf16_t* omix, int item, int tid) {
    const int c = item & 255, h = (item >> 8) & 3, b = item >> 10, tok0 = b * SEQL + c * 64;
    const int lane = tid & 63, w = tid >> 6, r32 = lane & 31, hi = lane >> 5;
    const u32x4 qv = L.qv, kv = L.kv, vv0 = L.vv0, vv1 = L.vv1;
    gla_preamble(lds, L.pre, tid);
    LAS float* BF = (LAS float*)(lds + G_BF); LAS float* BB = (LAS float*)(lds + G_BB);
    LAS bf16_t* QF = (LAS bf16_t*)(lds + G_Q0); LAS bf16_t* KF = QF + 64 * GP; LAS bf16_t* QB = KF + 64 * GP; LAS bf16_t* KB = QB + 64 * GP;
    LAS bf16_t* VT = (LAS bf16_t*)(lds + G_VT); LAS bf16_t* AF = (LAS bf16_t*)(lds + G_AF); LAS bf16_t* AB = (LAS bf16_t*)(lds + G_AB);
    { const int t = tid >> 3, d0 = (tid & 7) * 8;
        const float qf[8] = {bflo(qv.x), bfhi(qv.x), bflo(qv.y), bfhi(qv.y), bflo(qv.z), bfhi(qv.z), bflo(qv.w), bfhi(qv.w)};
        const float kf[8] = {bflo(kv.x), bfhi(kv.x), bflo(kv.y), bfhi(kv.y), bflo(kv.z), bfhi(kv.z), bflo(kv.w), bfhi(kv.w)};
        float oqf[8], okf[8], oqb[8], okb[8];
#pragma unroll
        for (int i = 0; i < 8; ++i) { const float bf = BF[t * 64 + d0 + i], bb = BB[t * 64 + d0 + i];
            oqf[i] = qf[i] * 0.125f * __expf(bf); okf[i] = kf[i] * __expf(-bf); oqb[i] = qf[i] * 0.125f * __expf(bb); okb[i] = kf[i] * __expf(-bb); }
        *(LAS u32x4*)(QF + t * GP + d0) = (u32x4){pk2(oqf[0], oqf[1]), pk2(oqf[2], oqf[3]), pk2(oqf[4], oqf[5]), pk2(oqf[6], oqf[7])};
        *(LAS u32x4*)(KF + t * GP + d0) = (u32x4){pk2(okf[0], okf[1]), pk2(okf[2], okf[3]), pk2(okf[4], okf[5]), pk2(okf[6], okf[7])};
        *(LAS u32x4*)(QB + t * GP + d0) = (u32x4){pk2(oqb[0], oqb[1]), pk2(oqb[2], oqb[3]), pk2(oqb[4], oqb[5]), pk2(oqb[6], oqb[7])};
        *(LAS u32x4*)(KB + t * GP + d0) = (u32x4){pk2(okb[0], okb[1]), pk2(okb[2], okb[3]), pk2(okb[4], okb[5]), pk2(okb[6], okb[7])}; }
    gla_store_vt(lds, vv0, vv1, tid);
    lds_barrier();
    { const int dir = w >> 2, w4 = w & 3, mt = w4 >> 1, ns = w4 & 1; const LAS bf16_t* Qd = dir ? QB : QF; const LAS bf16_t* Kd = dir ? KB : KF; LAS bf16_t* Ad = dir ? AB : AF;
        f32x16 acc = {};
#pragma unroll
        for (int ks = 0; ks < 4; ++ks) { const bf16x8 A = *(const LAS bf16x8*)(Qd + (mt * 32 + r32) * GP + ks * 16 + hi * 8), B = *(const LAS bf16x8*)(Kd + (ns * 32 + r32) * GP + ks * 16 + hi * 8);
            acc = __builtin_amdgcn_mfma_f32_32x32x16_bf16(A, B, acc, 0, 0, 0); }
#pragma unroll
        for (int r = 0; r < 16; ++r) { const int tt = mt * 32 + crow16(r, hi), ss = ns * 32 + r32; const bool keep = dir ? (ss >= tt) : (ss <= tt);
            Ad[tt * GP + ss] = f2bf(keep ? acc[r] : 0.f); } }
    lds_barrier();
    { const int mt = w >> 2, nv = w & 3; f32x16 acc = {}, acc2 = {};
#pragma unroll
        for (int ks = 0; ks < 4; ++ks) acc = __builtin_amdgcn_mfma_f32_32x32x16_bf16(*(const LAS bf16x8*)(AF + (mt * 32 + r32) * GP + ks * 16 + hi * 8), *(const LAS bf16x8*)(VT + (nv * 32 + r32) * GP + ks * 16 + hi * 8), acc, 0, 0, 0);
#pragma unroll
        for (int ks = 0; ks < 4; ++ks) acc2 = __builtin_amdgcn_mfma_f32_32x32x16_bf16(*(const LAS bf16x8*)(AB + (mt * 32 + r32) * GP + ks * 16 + hi * 8), *(const LAS bf16x8*)(VT + (nv * 32 + r32) * GP + ks * 16 + hi * 8), acc2, 0, 0, 0);
#pragma unroll
        for (int ks = 0; ks < 4; ++ks) acc = __builtin_amdgcn_mfma_f32_32x32x16_bf16(*(const LAS bf16x8*)(QF + (mt * 32 + r32) * GP + ks * 16 + hi * 8), L.s0[ks], acc, 0, 0, 0);
#pragma unroll
        for (int ks = 0; ks < 4; ++ks) acc2 = __builtin_amdgcn_mfma_f32_32x32x16_bf16(*(const LAS bf16x8*)(QB + (mt * 32 + r32) * GP + ks * 16 + hi * 8), L.s1[ks], acc2, 0, 0, 0);
        acc += acc2;
        LAS float* OS = (LAS float*)(lds + G_BF);
#pragma unroll
        for (int r = 0; r < 16; ++r) OS[(mt * 32 + crow16(r, hi)) * 132 + nv * 32 + r32] = acc[r]; }
    lds_barrier();
    { const int t = tid >> 3, dv0 = (tid & 7) * 16; const LAS float* OS = (const LAS float*)(lds + G_BF) + t * 132 + dv0;
        f32x4 o[4]; float ss = 0.f;
#pragma unroll
        for (int i = 0; i < 4; ++i) { o[i] = *(const LAS f32x4*)(OS + 4 * i); ss += (o[i].x * o[i].x + o[i].y * o[i].y) + (o[i].z * o[i].z + o[i].w * o[i].w); }
        ss += __shfl_xor(ss, 1); ss += __shfl_xor(ss, 2); ss += __shfl_xor(ss, 4);
        const float rstd = 1.0f / sqrtf(ss * (1.f / 128.f) + RMS_EPS);
        const u32x4 g0 = L.g0, g1 = L.g1;
        const float gg[16] = {bflo(g0.x), bfhi(g0.x), bflo(g0.y), bfhi(g0.y), bflo(g0.z), bfhi(g0.z), bflo(g0.w), bfhi(g0.w), bflo(g1.x), bfhi(g1.x), bflo(g1.y), bfhi(g1.y), bflo(g1.z), bfhi(g1.z), bflo(g1.w), bfhi(g1.w)};
        float res[16];
#pragma unroll
        for (int i = 0; i < 4; ++i) { const f32x4 on = *(const f32x4*)(onorm + dv0 + 4 * i);
#pragma unroll
            for (int e = 0; e < 4; ++e) { const float g = gg[4 * i + e]; res[4 * i + e] = o[i][e] * rstd * on[e] * (g * __builtin_amdgcn_rcpf(1.0f + __expf(-g))); } }
        bf16_t* op = omix + (size_t)(tok0 + t) * 1024 + h * 128 + dv0;
        *(u32x4*)op = (u32x4){pk2(res[0], res[1]), pk2(res[2], res[3]), pk2(res[4], res[5]), pk2(res[6], res[7])};
        *(u32x4*)(op + 8) = (u32x4){pk2(res[8], res[9]), pk2(res[10], res[11]), pk2(res[12], res[13]), pk2(res[14], res[15])}; }
    lds_barrier();
}

DI void qk_prep_item(bf16_t* proj, const float* qn, const float* kn, const float* tab, int tok, int j) {
    bf16_t* p = proj + (size_t)tok * NPROJ + (j < 8 ? C_AQ + j * 64 : C_AK + (j - 8) * 64);
    const float* wn = j < 8 ? qn : kn; const float sc = j < 8 ? attn_body::C2 : 1.0f;
    const int t = tok % SEQL, prow = t >> 6, pcol = 256 + (t & 63);
    float x[64]; float ss = 0.f;
#pragma unroll
    for (int i = 0; i < 8; ++i) { const u32x4 v = *(const u32x4*)(p + 8 * i);
        x[8 * i + 0] = bflo(v.x); x[8 * i + 1] = bfhi(v.x); x[8 * i + 2] = bflo(v.y); x[8 * i + 3] = bfhi(v.y); x[8 * i + 4] = bflo(v.z); x[8 * i + 5] = bfhi(v.z); x[8 * i + 6] = bflo(v.w); x[8 * i + 7] = bfhi(v.w); }
#pragma unroll
    for (int i = 0; i < 64; ++i) ss += x[i] * x[i];
    const float rstd = sc / sqrtf(ss * (1.f / 64.f) + RMS_EPS);
#pragma unroll
    for (int i = 0; i < 16; ++i) { const f32x4 w4 = *(const f32x4*)(wn + 4 * i);
        x[4 * i] *= rstd * w4.x; x[4 * i + 1] *= rstd * w4.y; x[4 * i + 2] *= rstd * w4.z; x[4 * i + 3] *= rstd * w4.w; }
    float y[64];
#pragma unroll
    for (int i = 0; i < 16; ++i) {
        const float cr = tab[(prow * 16 + i) * 2], sr = tab[(prow * 16 + i) * 2 + 1], cc = tab[(pcol * 16 + i) * 2], sn = tab[(pcol * 16 + i) * 2 + 1];
        y[i] = x[i] * cr - x[i + 16] * sr; y[i + 16] = x[i] * sr + x[i + 16] * cr;
        y[32 + i] = x[32 + i] * cc - x[48 + i] * sn; y[48 + i] = x[32 + i] * sn + x[48 + i] * cc; }
#pragma unroll
    for (int i = 0; i < 8; ++i) *(u32x4*)(p + 8 * i) = (u32x4){pk2(y[8 * i], y[8 * i + 1]), pk2(y[8 * i + 2], y[8 * i + 3]), pk2(y[8 * i + 4], y[8 * i + 5]), pk2(y[8 * i + 6], y[8 * i + 7])};
}


#if MK_DIAG
DI bool bad16(unsigned w) { return (w & 0x7F80u) == 0x7F80u || (w & 0x7F800000u) == 0x7F800000u; }
DI void chk16_2d(const bf16_t* p, int rows, int pitch, int col0, int ncols, unsigned* flag, int gt, int NGT) {
    bool bad = false; const int per = ncols / 8; const size_t n = (size_t)rows * per;
    for (size_t i = gt; i < n; i += NGT) { const size_t r = i / per; const int c = (int)(i % per); const u32x4 v = *(const u32x4*)(p + r * pitch + col0 + c * 8); bad |= bad16(v.x) | bad16(v.y) | bad16(v.z) | bad16(v.w); }
    if (bad) atomicOr(flag, 1u);
}
DI void chk32(const float* p, size_t n, unsigned* flag, int gt, int NGT) {
    bool bad = false;
    for (size_t i = gt; i < n / 4; i += NGT) { const u32x4 v = ((const u32x4*)p)[i]; bad |= ((v.x & 0x7F800000u) == 0x7F800000u) | ((v.y & 0x7F800000u) == 0x7F800000u) | ((v.z & 0x7F800000u) == 0x7F800000u) | ((v.w & 0x7F800000u) == 0x7F800000u); }
    if (bad) atomicOr(flag, 1u);
}
#endif
__global__ void __launch_bounds__(NTHR, 2) hymba_fwd(Args args) {
    __shared__ __attribute__((aligned(16))) unsigned char lds_raw[LDS_BYTES];
    LAS unsigned char* lds = (LAS unsigned char*)lds_raw;
    const int tid = threadIdx.x, lane = tid & 63, wave = __builtin_amdgcn_readfirstlane(tid >> 6);
    const int G = gridDim.x, bx = blockIdx.x;
    const int vcu = (G % 8 == 0) ? (bx % 8) * (G / 8) + bx / 8 : bx;
    unsigned char* ws = args.ws;
    const float* x_prompt = args.in[0]; const float* x_sample = args.in[1]; const float* ln_mix = args.in[2]; const float* w_in = args.in[3];
    const float* w_gk_f = args.in[4]; const float* b_gk_f = args.in[5]; const float* w_gk_b = args.in[6]; const float* b_gk_b = args.in[7];
    const float* gla_on = args.in[8]; const float* q_norm = args.in[9]; const float* k_norm = args.in[10]; const float* w_out = args.in[11];
    const float* ln_ffn = args.in[12]; const float* w_up = args.in[13]; const float* conv_w = args.in[14]; const float* conv_b = args.in[15];
    const float* w_down = args.in[16]; const float* ln_final = args.in[17];
    float* out = args.out;
    bf16_t* WinT = (bf16_t*)(ws + WS_WIN); bf16_t* WoutT = (bf16_t*)(ws + WS_WOUT); bf16_t* WupT = (bf16_t*)(ws + WS_WUP); bf16_t* WdnT = (bf16_t*)(ws + WS_WDN);
    float* rope = (float*)(ws + WS_ROPE); float* dec = (float*)(ws + WS_DEC);
    bf16_t* Hbuf = (bf16_t*)(ws + WS_H); bf16_t* Hrow = Hbuf + 1024;
    bf16_t* H2 = (bf16_t*)(ws + WS_H2); float* ssq = (float*)(ws + WS_SSQ); float* ssq2 = (float*)(ws + WS_SSQ2);
    bf16_t* proj = (bf16_t*)(ws + WS_A); bf16_t* act = (bf16_t*)(ws + WS_A); bf16_t* sbuf = (bf16_t*)(ws + WS_S);
    const int lo = args.ph_lo, hi = args.ph_hi;
    XcdBarrier xbar; xbar.bar = (unsigned*)(ws + WS_BAR); xbar.x = 0; xbar.st = (volatile LAS unsigned*)(lds + LDS_BARST);
    if (!MK_PER_PHASE) { if (tid < 2) ((volatile LAS unsigned*)(lds + LDS_BARST))[tid] = 0u; __syncthreads(); xbar = xcd_barrier_post((unsigned*)(ws + WS_BAR), (volatile LAS unsigned*)(lds + LDS_BARST)); }
    const int gw = vcu * NWAVES + wave, NGW = G * NWAVES, gt = bx * NTHR + tid, NGT = G * NTHR;

#if MK_DIAG
    if (args.chk >= 0) { unsigned* fl = (unsigned*)(ws + WS_FLAG); const int k = args.chk;
        if (k == 0) { chk16_2d(WinT, 1, 0, 0, (int)((WS_WDN + (size_t)1024 * DFF * 2) / 2), fl + 0, gt, NGT); chk32(rope, 320 * 32, fl + 0, gt, NGT); chk16_2d(Hrow, TOK, 1024, 0, 1024, fl + 1, gt, NGT); }
        if (k == 1) chk16_2d(proj, TOK, NPROJ, 0, NPROJ, fl + 2, gt, NGT);
        if (k == 2) { chk16_2d(proj, TOK, NPROJ, 0, NPROJ, fl + 3, gt, NGT); chk16_2d(sbuf, 2 * NITEM, 8192, 0, 8192, fl + 4, gt, NGT); chk32(dec, (size_t)2 * NITEM * 64, fl + 16, gt, NGT); }
        if (k == 3) chk16_2d(sbuf, 2 * NITEM, 8192, 0, 8192, fl + 5, gt, NGT);
        if (k == 4) { chk16_2d(Hrow, TOK, 1024, 0, 512, fl + 6, gt, NGT); chk16_2d(Hrow, TOK, 1024, 512, 512, fl + 7, gt, NGT); }
        if (k == 5) chk32(out, (size_t)TOK * 1024, fl + 8, gt, NGT);
        if (k == 6) chk16_2d(Hbuf, TOK + 257, 1024, 0, 1024, fl + 9, gt, NGT);
        if (k == 7) chk16_2d(act, TOK, DFF, 0, DFF, fl + 10, gt, NGT);
        if (k == 8) chk32(out, (size_t)TOK * 1024, fl + 11, gt, NGT);
        if (k == 99) { const int order[16] = {0, 1, 2, 3, 12, 13, 14, 15, 16, 4, 5, 6, 8, 9, 10, 11}; int first = -1;
#pragma unroll
            for (int i = 15; i >= 0; --i) if (fl[order[i]]) first = i;
            float v = first < 0 ? 1.0f : (float)(first + 2); if (fl[7]) v *= 30.0f;
            for (size_t i = gt; i < (size_t)TOK * 1024; i += NGT) out[i] = v; }
        return; }
#endif
#define IN(k) (lo <= (k) && (k) < hi)
#define SEAM(k) do { if (IN(k) && IN((k) + 1)) { xcd_barrier(xbar); } } while (0)
    if (args.ph_hi > 1000) cg::this_grid().sync();

    if (IN(0)) {
        LAS float* scr = (LAS float*)(lds + wave * 16384);
        constexpr int I_IN = 16 * (INW / 32), I_OUT = 16 * 32, I_UP = 16 * (NUP / 32), I_DN = (DFF / 64) * 32, NIT = I_IN + I_OUT + I_UP + I_DN;
        for (int it = gw; it < NIT; it += NGW) {
            int r = it;
            if (r < I_IN) { p0_transpose_item(w_in, 1024, INW, WinT, scr, r, lane, 1); continue; } r -= I_IN;
            if (r < I_OUT) { p0_transpose_item(w_out, 1024, 1024, WoutT, scr, r, lane, 0); continue; } r -= I_OUT;
            if (r < I_UP) { p0_transpose_item(w_up, 1024, NUP, WupT, scr, r, lane, 2); continue; } r -= I_UP;
            p0_transpose_item(w_down, DFF, 1024, WdnT, scr, r, lane, 0);
        }
        for (int i = gt; i < (NPROJ - INW) * 1024 / 8; i += NGT) ((u32x4*)(WinT + (size_t)INW * 1024))[i] = (u32x4){0u, 0u, 0u, 0u};
        for (int i = gt; i < 320 * 16; i += NGT) { const int p = i >> 4, f = i & 15; const int pos = p < 256 ? p : p - 256;
            double inv = 1.0; for (int k = 0; k < f; ++k) inv *= 0.56234132519034908;
            double turns = (double)pos * inv * 0.15915494309189535; turns -= floor(turns); const float xt = (float)turns;
            rope[2 * i] = __builtin_amdgcn_cosf(xt); rope[2 * i + 1] = __builtin_amdgcn_sinf(xt); }
        for (int i = gt; i < TOK; i += NGT) { ssq[i] = 0.f; ssq2[i] = 0.f; }
        for (int i = gt; i < 257 * 128; i += NGT) { const int r = i >> 7, c = i & 127; const size_t row = r == 0 ? 0 : (size_t)TOK + r; ((u32x4*)(H2 + row * 1024))[c] = (u32x4){0u, 0u, 0u, 0u}; }
        for (int m = gw; m < TOK; m += NGW) { const float* xr = m < 2 * SEQL ? x_prompt + (size_t)m * 1024 : x_sample + (size_t)(m - 2 * SEQL) * 1024;
            rms_row_to_bf16(xr, ln_mix, Hrow + (size_t)m * 1024, lane); }
    }
    SEAM(0);
    if (IN(1)) {
        pg8::Gemm g{Hbuf, WinT, TOK, NPROJ, 1024}; pg8::StaticOrder S; S.init(TOK, NPROJ, G, bx, 1);
        pg8::EpiBf16<0> E{proj, NPROJ, nullptr, 0, 0, 1.f};
        pg8::gemm_phase<pg8::EpiBf16<0>, pg8::StaticOrder, true, true>(lds, g, S, E);
    }
    SEAM(1);
    if (IN(2)) {
        for (int i = gt; i < TOK * 10; i += NGT) qk_prep_item(proj, q_norm, k_norm, rope, i / 10, i % 10);
        const GlaIn gi{proj, w_gk_f, b_gk_f, w_gk_b, b_gk_b};
        for (int rep = 0; rep < REP_G1; ++rep) { G1Loads cur; g1_issue(cur, gi, vcu < NITEM ? vcu : 0, tid);
            for (int it = vcu; it < NITEM; it += G) { G1Loads nxt; g1_issue(nxt, gi, it + G < NITEM ? it + G : it, tid);
                gla_g1_item(lds, cur, sbuf, dec, it, tid, (unsigned*)(ws + WS_FLAG)); cur = nxt; } }
    }
    SEAM(2);
    if (IN(3)) {
        if (gt < 24 * 4096) { const int chain = gt >> 12, e2 = gt & 4095, dir = chain / 12, bh = chain % 12;
            unsigned* sp = (unsigned*)(sbuf + (size_t)(dir * NITEM + bh * 256) * 8192) + e2;
            const float* dp = dec + (size_t)(dir * NITEM + bh * 256) * 64 + ((2 * e2) & 63);
            float S0 = 0.f, S1 = 0.f;
            typedef float f32x2 __attribute__((ext_vector_type(2)));
            for (int cb = 0; cb < 256; cb += 32) { unsigned v[32]; f32x2 dd[32];
#pragma unroll
                for (int i = 0; i < 32; ++i) { const int c = dir ? 255 - (cb + i) : cb + i; v[i] = sp[(size_t)c * 4096]; dd[i] = *(const f32x2*)(dp + c * 64); }
#pragma unroll
                for (int i = 0; i < 32; ++i) { const int c = dir ? 255 - (cb + i) : cb + i; sp[(size_t)c * 4096] = pk2(S0, S1); S0 = S0 * dd[i].x + bflo(v[i]); S1 = S1 * dd[i].y + bfhi(v[i]); } } }
    }
    SEAM(3);
    if (IN(4)) {
        const GlaIn gi{proj, w_gk_f, b_gk_f, w_gk_b, b_gk_b};
        for (int rep = 0; rep < REP_G3; ++rep) { G3Loads cur; g3_issue(cur, gi, sbuf, vcu < NITEM ? vcu : 0, tid);
            for (int it = vcu; it < NITEM; it += G) { G3Loads nxt; g3_issue(nxt, gi, sbuf, it + G < NITEM ? it + G : it, tid);
                gla_g3_item(lds, cur, gla_on, Hrow, it, tid); cur = nxt; } }
        float mq = 0.f, mk = 0.f;
        for (int i = 0; i < 64; ++i) { mq = fmaxf(mq, fabsf(q_norm[i])); mk = fmaxf(mk, fabsf(k_norm[i])); }
        const float mfix = attn_body::C2 * 64.0f * mq * mk * 1.02f + 0.25f;
        for (int rep = 0; rep < REP_ATT; ++rep) for (int id = vcu; id < NSEQ * 8 * 64; id += G) {
            const int pair = id >> 8, v = id & 255, b = pair >> 1, kvh = pair & 1, h = kvh * 4 + (v >> 6), qb = v & 63;
            const attn_body::bf16* base = (const attn_body::bf16*)proj + (size_t)b * SEQL * NPROJ;
            attn_body::attn_unit<8>(qb, base + C_AQ + h * 64, base + C_AK + kvh * 64, base + C_AV + kvh * 64, (attn_body::bf16*)Hrow + (size_t)b * SEQL * 1024 + 512 + h * 64, (char*)lds_raw, mfix);
        }
    }
    SEAM(4);
    if (IN(5)) {
        pg8::Gemm g{Hbuf, WoutT, TOK, 1024, 1024}; pg8::StaticOrder S; S.init(TOK, 1024, G, bx, 1);
        pg8::EpiResidNorm E{x_prompt, x_sample, 2 * SEQL, out, H2 + 1024, ln_ffn, ssq};
        pg8::gemm_phase<pg8::EpiResidNorm, pg8::StaticOrder, true, true>(lds, g, S, E);
    }
    SEAM(5);
    if (IN(7)) {
#if P7_PIPE
        pg8::Gemm g{H2, WupT, TOK, NUP, 1024}; const pg8::UpOrder S{G, vcu};
        const pg8::EpiConvGate2 E{act, conv_w, conv_b, (LAS float*)(lds + 131072), ssq};
        for (int rep = 0; rep < REP_P7; ++rep) pg8::gemm_phase<pg8::EpiConvGate2, pg8::UpOrder, true, true>(lds, g, S, E);
#else
        constexpr int MT = 65, NUNIT = NSEQ * MT * 22;
        pg8::Gemm g{H2, WupT, TOK, NUP, 1024};
        for (int rep = 0; rep < REP_P7; ++rep) for (int id = vcu; id < NUNIT; id += G) {
            const int mtile = id / 22, pn = id % 22, b = mtile / MT, i = mtile % MT;
            pg8::OneUnit S; S.u0.pm = mtile; S.u0.pn = pn; S.u0.arow = b * SEQL + 254 * i;
            pg8::EpiConvGate E{act, conv_w, conv_b, 254 * i - 1, b * SEQL, ssq};
            pg8::gemm_phase<pg8::EpiConvGate, pg8::OneUnit, false, true>(lds, g, S, E);
        }
#endif
    }
#if MK_CMP7
    if (IN(7)) {
        xcd_barrier(xbar);
        bf16_t* act_ref = (bf16_t*)(ws + 388 * MiB);
        pg8::Gemm g2{Hbuf, WupT, TOK, NUP, 1024};
        for (int id = vcu; id < 65 * 22; id += G) { const int mtile = id / 22, pn = id % 22;
            pg8::OneUnit S1; S1.u0.pm = mtile; S1.u0.pn = pn; S1.u0.arow = 254 * mtile;
            pg8::EpiConvGate E1{act_ref, conv_w, conv_b, 254 * mtile - 1, 0, ssq};
            pg8::gemm_phase<pg8::EpiConvGate, pg8::OneUnit, false, true>(lds, g2, S1, E1); }
        xcd_barrier(xbar);
        unsigned* fl = (unsigned*)(ws + WS_FLAG);
        unsigned cnt[6] = {0u, 0u, 0u, 0u, 0u, 0u};
        for (size_t i = gt; i < (size_t)SEQL * DFF; i += NGT) { const int t = (int)(i / DFF); const int j = t % 254 + 1;
            const float a = bflo((unsigned)act[i]), b = bflo((unsigned)act_ref[i]); const bool bad = !(fabsf(a - b) <= 0.03f * (fabsf(a) + fabsf(b)) + 2e-3f);
            const int cat = (j % 64 == 0 || j % 64 == 63) ? 2 : ((j % 16 == 0 || j % 16 == 15) ? 1 : 0);
            if (cat == 0) { cnt[1]++; cnt[0] += bad; } else if (cat == 1) { cnt[3]++; cnt[2] += bad; } else { cnt[5]++; cnt[4] += bad; } }
#pragma unroll
        for (int k = 0; k < 6; ++k) if (cnt[k]) atomicAdd(fl + 20 + k, cnt[k]);
    }
#endif
    SEAM(7);
    if (IN(8)) {
        pg8::Gemm g{act, WdnT, TOK, 1024, DFF}; pg8::StaticOrder S; S.init(TOK, 1024, G, bx, 0);
        pg8::EpiDown E{H2 + 1024, ln_ffn, Hrow, ssq2};
        pg8::gemm_phase<pg8::EpiDown, pg8::StaticOrder, true, true>(lds, g, S, E);
    }
    SEAM(8);
#if MK_CMP7
    if (IN(9)) { const unsigned* fl = (const unsigned*)(ws + WS_FLAG); int code = 0;
        if ((float)fl[20] > 0.01f * (float)fl[21]) code |= 1; if ((float)fl[22] > 0.01f * (float)fl[23]) code |= 2; if ((float)fl[24] > 0.01f * (float)fl[25]) code |= 4;
        const float v = (float)(2 + code); for (size_t i = gt; i < (size_t)TOK * 1024; i += NGT) out[i] = v; }
#else
    if (IN(9)) { for (int m = gw; m < TOK; m += NGW) rms_row_final(Hrow + (size_t)m * 1024, ssq2[m], ln_final, out + (size_t)m * 1024, lane); }
#endif
#undef IN
#undef SEAM
}

extern "C" void kernel_launch(void* const* d_in, const int* in_sizes, int n_in, void* d_out, int out_size, void* d_ws, size_t ws_size, hipStream_t stream) {
    static int grid = 0;
    if (grid == 0) {
        if (n_in != 18 || out_size != TOK * 1024 || ws_size < WS_END) { fprintf(stderr, "kernel_launch: unexpected shapes (n_in %d out %d ws %zu)\n", n_in, out_size, ws_size); grid = -1; return; }
        int dev = 0, cus = 0, per_cu = 0;
        (void)hipGetDevice(&dev); (void)hipDeviceGetAttribute(&cus, hipDeviceAttributeMultiprocessorCount, dev);
        if (hipOccupancyMaxActiveBlocksPerMultiprocessor(&per_cu, (const void*)hymba_fwd, NTHR, 0) != hipSuccess || per_cu < 1) { fprintf(stderr, "kernel_launch: occupancy query says %d\n", per_cu); per_cu = 1; }
        (void)hipGetLastError();
        grid = cus * 1;
        if (grid % 8 != 0 || grid <= 0) grid = 256;
    }
    if (grid < 0) return;
    Args a{};
    for (int i = 0; i < 18; ++i) a.in[i] = (const float*)d_in[i];
    a.out = (float*)d_out; a.ws = (unsigned char*)d_ws;
#if MK_PER_PHASE
    a.chk = -1;
#if MK_DIAG
    (void)hipMemsetAsync((char*)d_ws + WS_FLAG, 0, 128, stream);
#endif
    for (int p = 0; p < 10; ++p) { a.ph_lo = p; a.ph_hi = p + 1; a.chk = -1; hipLaunchKernelGGL(hymba_fwd, dim3(grid), dim3(NTHR), 0, stream, a);
#if MK_DIAG
        if (p <= 8) { a.ph_lo = a.ph_hi = -1; a.chk = p; hipLaunchKernelGGL(hymba_fwd, dim3(grid), dim3(NTHR), 0, stream, a); }
        if (p == 9) { a.ph_lo = a.ph_hi = -1; a.chk = 99; hipLaunchKernelGGL(hymba_fwd, dim3(grid), dim3(NTHR), 0, stream, a); }
#endif
    }
#else
    a.ph_lo = 0; a.ph_hi = 10; a.chk = -1;
    (void)hipMemsetAsync((char*)d_ws + WS_BAR, 0, XCD_BAR_WORDS * 4, stream);
#if MK_CMP7
    (void)hipMemsetAsync((char*)d_ws + WS_FLAG, 0, 256, stream);
#endif
    void* kargs[] = {&a};
    hipError_t e = hipLaunchCooperativeKernel((const void*)hymba_fwd, dim3(grid), dim3(NTHR), kargs, 0, stream);
    if (e != hipSuccess) fprintf(stderr, "kernel_launch: cooperative launch failed: %s (grid %d)\n", hipGetErrorString(e), grid);
#endif
}
```
